# Optimizing an MI355X kernel written in HIP

```python
import jax, jax.numpy as jnp
from jax import lax
import numpy as np

D_MODEL = 1024
BATCH = 8
SEQ = 2048
DEPTH = 4

N_HEADS = 8
HEAD_DIM = D_MODEL // N_HEADS
MOBA_BLOCK = 256
MOBA_TOPK = 3
Q_CHUNK = 16
NEG_INF = -1e30
LRU_WIDTH = D_MODEL
LRU_BLOCKS = 8
LRU_BLOCK_DIM = LRU_WIDTH // LRU_BLOCKS
CONV_WIDTH = 4
LRU_C = 8.0
FFN_HIDDEN = -(-8 * D_MODEL // (3 * 256)) * 256
DN_ALPHA = (2 * DEPTH) ** 0.25
DN_BETA = (8 * DEPTH) ** -0.25
LN_EPS = 1e-5
N_ATTN_LAYERS = (DEPTH + 1) // 2
N_LRU_LAYERS = DEPTH // 2

kernel_name = "moba_rglru_deepnorm_hybrid"


def layer_norm(x, g, b):
    xf = x.astype(jnp.float32)
    mu = jnp.mean(xf, axis=-1, keepdims=True)
    var = jnp.mean(jnp.square(xf - mu), axis=-1, keepdims=True)
    return ((xf - mu) * lax.rsqrt(var + LN_EPS) * g.astype(jnp.float32) + b.astype(jnp.float32)).astype(x.dtype)


def alibi_slopes(n_heads):
    return jnp.exp2(-8.0 * (jnp.arange(n_heads, dtype=jnp.float32) + 1.0) / n_heads)


def moba_attention(x, w_qkv, w_o):
    B, S, _ = x.shape
    f32 = jnp.float32
    qkv = x @ w_qkv
    q, k, v = jnp.split(qkv, 3, axis=-1)
    to_heads = lambda t: t.reshape(B, S, N_HEADS, HEAD_DIM).transpose(0, 2, 1, 3)
    q, k, v = to_heads(q), to_heads(k), to_heads(v)

    n_blk = -(-S // MOBA_BLOCK)
    pad = n_blk * MOBA_BLOCK - S
    kb = jnp.pad(k, ((0, 0), (0, 0), (0, pad), (0, 0))).reshape(B, N_HEADS, n_blk, MOBA_BLOCK, HEAD_DIM)
    vb = jnp.pad(v, ((0, 0), (0, 0), (0, pad), (0, 0))).reshape(B, N_HEADS, n_blk, MOBA_BLOCK, HEAD_DIM)

    kmean = jnp.mean(kb.astype(f32), axis=3)
    pos = jnp.arange(S)
    q_blk = pos // MOBA_BLOCK
    gate = jnp.einsum('bhsd,bhnd->bhsn', q.astype(f32), kmean)
    past = jnp.arange(n_blk)[None, :] < q_blk[:, None]
    gate = jnp.where(past[None, None], gate, -jnp.inf)
    k_sel = min(MOBA_TOPK, n_blk)
    _, sel = lax.top_k(gate, k_sel)
    sel_valid = sel < q_blk[None, None, :, None]

    scale = HEAD_DIM ** -0.5
    slopes = alibi_slopes(N_HEADS)
    b_ix = jnp.arange(B)[:, None, None, None]
    h_ix = jnp.arange(N_HEADS)[None, :, None, None]
    offs = jnp.arange(MOBA_BLOCK)
    n_chunks = S // Q_CHUNK

    def chunk(c):
        t0 = c * Q_CHUNK
        qc = lax.dynamic_slice_in_dim(q, t0, Q_CHUNK, axis=2).astype(f32)
        sc = lax.dynamic_slice_in_dim(sel, t0, Q_CHUNK, axis=2)
        vc = lax.dynamic_slice_in_dim(sel_valid, t0, Q_CHUNK, axis=2)
        t = t0 + jnp.arange(Q_CHUNK)
        kg = kb[b_ix, h_ix, sc].astype(f32)
        vg = vb[b_ix, h_ix, sc].astype(f32)
        s_sel = jnp.einsum('bhqd,bhqnkd->bhqnk', qc, kg) * scale
        key_pos = sc[..., None] * MOBA_BLOCK + offs
        dist_sel = (t[None, None, :, None, None] - key_pos).astype(f32)
        s_sel = s_sel - slopes[None, :, None, None, None] * dist_sel
        s_sel = jnp.where(vc[..., None], s_sel, NEG_INF)
        own = t0 // MOBA_BLOCK
        ko = lax.dynamic_index_in_dim(kb, own, axis=2, keepdims=False).astype(f32)
        vo = lax.dynamic_index_in_dim(vb, own, axis=2, keepdims=False).astype(f32)
        dist_own = t[:, None] - (own * MOBA_BLOCK + offs)[None, :]
        s_own = jnp.einsum('bhqd,bhkd->bhqk', qc, ko) * scale
        s_own = jnp.where(dist_own[None, None] >= 0,
                          s_own - slopes[None, :, None, None] * dist_own.astype(f32)[None, None],
                          NEG_INF)
        scores = jnp.concatenate([s_sel.reshape(B, N_HEADS, Q_CHUNK, k_sel * MOBA_BLOCK), s_own], axis=-1)
        p = jax.nn.softmax(scores, axis=-1)
        p_sel = p[..., :k_sel * MOBA_BLOCK].reshape(B, N_HEADS, Q_CHUNK, k_sel, MOBA_BLOCK)
        p_own = p[..., k_sel * MOBA_BLOCK:]
        out = jnp.einsum('bhqnk,bhqnkd->bhqd', p_sel, vg) + jnp.einsum('bhqk,bhkd->bhqd', p_own, vo)
        return out.astype(x.dtype)

    o = lax.map(chunk, jnp.arange(n_chunks))
    o = o.transpose(1, 2, 0, 3, 4).reshape(B, N_HEADS, S, HEAD_DIM)
    o = o.transpose(0, 2, 1, 3).reshape(B, S, N_HEADS * HEAD_DIM)
    return o @ w_o


def rglru_block(x, w_in, conv_w, conv_b, w_a, b_a, w_x, b_x, lam, w_out):
    B, S, _ = x.shape
    f32 = jnp.float32
    xb, yb = jnp.split(x @ w_in, 2, axis=-1)
    gate_branch = jax.nn.gelu(yb)
    xp = jnp.pad(xb, ((0, 0), (CONV_WIDTH - 1, 0), (0, 0)))
    xc = sum(xp[:, tap:tap + S] * conv_w[tap] for tap in range(CONV_WIDTH)) + conv_b
    xg = xc.reshape(B, S, LRU_BLOCKS, LRU_BLOCK_DIM)
    r = jax.nn.sigmoid(jnp.einsum('bsgc,gcd->bsgd', xg, w_a).reshape(B, S, LRU_WIDTH) + b_a)
    i = jax.nn.sigmoid(jnp.einsum('bsgc,gcd->bsgd', xg, w_x).reshape(B, S, LRU_WIDTH) + b_x)
    log_a = -LRU_C * r.astype(f32) * jax.nn.softplus(-lam.astype(f32))
    a = jnp.exp(log_a)
    b_in = jnp.sqrt(-jnp.expm1(2.0 * log_a)) * (i * xc).astype(f32)

    def combine(left, right):
        a1, b1 = left
        a2, b2 = right
        return a1 * a2, a2 * b1 + b2

    _, h = lax.associative_scan(combine, (a, b_in), axis=1)
    return (h.astype(x.dtype) * gate_branch) @ w_out


def swiglu(x, w_in, w_out):
    g, u = jnp.split(x @ w_in, 2, axis=-1)
    return (jax.nn.silu(g) * u) @ w_out


def setup_inputs(seed: int = 0) -> dict:
    key = jax.random.key(seed)
    ks = jax.random.split(key, 20)
    f32 = jnp.float32
    D, DR, F, G, DG = D_MODEL, LRU_WIDTH, FFN_HIDDEN, LRU_BLOCKS, LRU_BLOCK_DIM
    nA, nR = N_ATTN_LAYERS, N_LRU_LAYERS
    nrm = lambda k, shape, s: jax.random.normal(k, shape, f32) * s
    x = nrm(ks[0], (BATCH, SEQ, D), 1.0)
    attn_w_qkv = nrm(ks[1], (nA, D, 3 * D), D ** -0.5)
    attn_w_o = nrm(ks[2], (nA, D, D), D ** -0.5 * DN_BETA)
    lru_w_in = nrm(ks[3], (nR, D, 2 * DR), D ** -0.5)
    lru_conv_w = nrm(ks[4], (nR, CONV_WIDTH, DR), CONV_WIDTH ** -0.5)
    lru_conv_b = nrm(ks[5], (nR, DR), 0.01)
    lru_w_a = nrm(ks[6], (nR, G, DG, DG), DG ** -0.5)
    lru_b_a = nrm(ks[7], (nR, DR), 0.01)
    lru_w_x = nrm(ks[8], (nR, G, DG, DG), DG ** -0.5)
    lru_b_x = nrm(ks[9], (nR, DR), 0.01)
    u = jax.random.uniform(ks[10], (nR, DR), f32, 0.9, 0.999)
    p = u ** (1.0 / LRU_C)
    lru_lambda = jnp.log(p) - jnp.log1p(-p)
    lru_w_out = nrm(ks[11], (nR, DR, D), DR ** -0.5 * DN_BETA)
    ffn_w_in = nrm(ks[12], (DEPTH, D, 2 * F), D ** -0.5)
    ffn_w_out = nrm(ks[13], (DEPTH, F, D), F ** -0.5 * DN_BETA)
    ln_g = 1.0 + nrm(ks[14], (DEPTH, 2, D), 0.02)
    ln_b = nrm(ks[15], (DEPTH, 2, D), 0.02)
    return {"x": x, "attn_w_qkv": attn_w_qkv, "attn_w_o": attn_w_o,
            "lru_w_in": lru_w_in, "lru_conv_w": lru_conv_w, "lru_conv_b": lru_conv_b,
            "lru_w_a": lru_w_a, "lru_b_a": lru_b_a, "lru_w_x": lru_w_x, "lru_b_x": lru_b_x,
            "lru_lambda": lru_lambda, "lru_w_out": lru_w_out,
            "ffn_w_in": ffn_w_in, "ffn_w_out": ffn_w_out, "ln_g": ln_g, "ln_b": ln_b}


def reference(x, attn_w_qkv, attn_w_o, lru_w_in, lru_conv_w, lru_conv_b, lru_w_a, lru_b_a,
              lru_w_x, lru_b_x, lru_lambda, lru_w_out, ffn_w_in, ffn_w_out, ln_g, ln_b):
    h = x
    for i in range(DEPTH):
        j = i // 2
        if i % 2 == 0:
            mix = moba_attention(h, attn_w_qkv[j], attn_w_o[j])
        else:
            mix = rglru_block(h, lru_w_in[j], lru_conv_w[j], lru_conv_b[j], lru_w_a[j], lru_b_a[j],
                              lru_w_x[j], lru_b_x[j], lru_lambda[j], lru_w_out[j])
        h = layer_norm(DN_ALPHA * h + mix, ln_g[i, 0], ln_b[i, 0])
        h = layer_norm(DN_ALPHA * h + swiglu(h, ffn_w_in[i], ffn_w_out[i]), ln_g[i, 1], ln_b[i, 1])
    return h
```

```cpp
#include <hip/hip_runtime.h>
#include <cstdio>
namespace nv {
constexpr int S = 2048, D = 1024, H = 8, HD = 128, BLK = 256, NBLK = 8, F = 2816, G = 8, DG = 128;
constexpr float ALPHA = 1.681792830507429f;
constexpr float EPS = 1e-5f;

template <bool DUAL>
__global__ void __launch_bounds__(256) gemm(const float* __restrict__ A, const float* __restrict__ B, float* __restrict__ C,
                                            int M, int N, int K, int ldb, int dual_off) {
    __shared__ float As[16][64 + 1];
    __shared__ float Bs[16][64 + 1];
    __shared__ float B2s[DUAL ? 16 : 1][64 + 1];
    const int tx = threadIdx.x & 15, ty = threadIdx.x >> 4;
    const int m0 = blockIdx.y * 64, n0 = blockIdx.x * 64;
    float acc[4][4] = {}, acc2[4][4] = {};
    for (int k0 = 0; k0 < K; k0 += 16) {
        for (int i = threadIdx.x; i < 64 * 16; i += 256) {
            const int r = i >> 4, c = i & 15;
            As[c][r] = A[(size_t)(m0 + r) * K + k0 + c];
        }
        for (int i = threadIdx.x; i < 16 * 64; i += 256) {
            const int r = i >> 6, c = i & 63;
            Bs[r][c] = B[(size_t)(k0 + r) * ldb + n0 + c];
            if (DUAL) B2s[r][c] = B[(size_t)(k0 + r) * ldb + dual_off + n0 + c];
        }
        __syncthreads();
#pragma unroll
        for (int kk = 0; kk < 16; ++kk) {
            float a[4], b[4], b2[4];
#pragma unroll
            for (int i = 0; i < 4; ++i) a[i] = As[kk][ty * 4 + i];
#pragma unroll
            for (int j = 0; j < 4; ++j) { b[j] = Bs[kk][tx * 4 + j]; if (DUAL) b2[j] = B2s[kk][tx * 4 + j]; }
#pragma unroll
            for (int i = 0; i < 4; ++i)
#pragma unroll
                for (int j = 0; j < 4; ++j) { acc[i][j] = fmaf(a[i], b[j], acc[i][j]); if (DUAL) acc2[i][j] = fmaf(a[i], b2[j], acc2[i][j]); }
        }
        __syncthreads();
    }
#pragma unroll
    for (int i = 0; i < 4; ++i)
#pragma unroll
        for (int j = 0; j < 4; ++j) {
            float v = acc[i][j];
            if (DUAL) { const float g = v; v = g / (1.0f + expf(-g)) * acc2[i][j]; }
            C[(size_t)(m0 + ty * 4 + i) * N + n0 + tx * 4 + j] = v;
        }
}

__global__ void __launch_bounds__(256) ln_res(const float* __restrict__ hin, const float* __restrict__ mix, const float* __restrict__ g,
                                              const float* __restrict__ b, float* __restrict__ hout, int M) {
    const int row = blockIdx.x * 4 + (threadIdx.x >> 6), lane = threadIdx.x & 63;
    if (row >= M) return;
    float v[16]; float s = 0.f;
#pragma unroll
    for (int j = 0; j < 16; ++j) { const int c = lane + 64 * j; v[j] = ALPHA * hin[(size_t)row * D + c] + mix[(size_t)row * D + c]; s += v[j]; }
    for (int o = 32; o >= 1; o >>= 1) s += __shfl_xor(s, o);
    const float mu = s * (1.0f / D); float q = 0.f;
#pragma unroll
    for (int j = 0; j < 16; ++j) { const float d = v[j] - mu; q += d * d; }
    for (int o = 32; o >= 1; o >>= 1) q += __shfl_xor(q, o);
    const float rstd = 1.0f / sqrtf(q * (1.0f / D) + EPS);
#pragma unroll
    for (int j = 0; j < 16; ++j) { const int c = lane + 64 * j; hout[(size_t)row * D + c] = (v[j] - mu) * rstd * g[c] + b[c]; }
}

__global__ void kmean_k(const float* __restrict__ qkv, float* __restrict__ kmean) {
    const int idx = blockIdx.x, n = idx % NBLK, h = (idx / NBLK) % H, b = idx / (NBLK * H), d = threadIdx.x;
    float s = 0.f;
    for (int t = 0; t < BLK; ++t) s += qkv[(size_t)(b * S + n * BLK + t) * 3 * D + D + h * HD + d];
    kmean[(size_t)idx * HD + d] = s * (1.0f / BLK);
}

__global__ void __launch_bounds__(256) attn(const float* __restrict__ qkv, const float* __restrict__ kmean, float* __restrict__ o) {
    __shared__ float qs[HD];
    __shared__ float sc[4 * BLK];
    __shared__ float red[256];
    __shared__ int selb[4];
    __shared__ float gate[NBLK];
    const int t = blockIdx.x % S, h = (blockIdx.x / S) % H, b = blockIdx.x / (S * H), tid = threadIdx.x;
    const int qb = t / BLK;
    const float* qrow = qkv + (size_t)(b * S + t) * 3 * D + h * HD;
    if (tid < HD) qs[tid] = qrow[tid];
    __syncthreads();
    if (tid < NBLK) {
        float s = 0.f; const float* km = kmean + ((size_t)(b * H + h) * NBLK + tid) * HD;
        for (int d = 0; d < HD; ++d) s += qs[d] * km[d];
        gate[tid] = s;
    }
    __syncthreads();
    if (tid == 0) {
        unsigned used = 0u;
        for (int k = 0; k < 3; ++k) {
            int best = -1; float bv = 0.f;
            for (int n = 0; n < qb; ++n) if (!((used >> n) & 1u) && (best < 0 || gate[n] > bv)) { best = n; bv = gate[n]; }
            selb[k] = best; if (best >= 0) used |= 1u << best;
        }
        selb[3] = qb;
    }
    __syncthreads();
    const float slope = exp2f(-8.0f * (float)(h + 1) / (float)H), scale = 0.08838834764831845f;
    for (int sgm = 0; sgm < 4; ++sgm) {
        const int nb = selb[sgm]; float sv = -1e30f;
        if (nb >= 0) {
            const int kp = nb * BLK + tid;
            if (kp <= t) {
                const float* krow = qkv + (size_t)(b * S + kp) * 3 * D + D + h * HD;
                float s = 0.f; for (int d = 0; d < HD; ++d) s += qs[d] * krow[d];
                sv = s * scale - slope * (float)(t - kp);
            }
        }
        sc[sgm * BLK + tid] = sv;
    }
    __syncthreads();
    float mx = fmaxf(fmaxf(sc[tid], sc[BLK + tid]), fmaxf(sc[2 * BLK + tid], sc[3 * BLK + tid]));
    red[tid] = mx; __syncthreads();
    for (int o2 = 128; o2 >= 1; o2 >>= 1) { if (tid < o2) red[tid] = fmaxf(red[tid], red[tid + o2]); __syncthreads(); }
    mx = red[0]; __syncthreads();
    float ls = 0.f;
    for (int sgm = 0; sgm < 4; ++sgm) { const float p = expf(sc[sgm * BLK + tid] - mx); sc[sgm * BLK + tid] = p; ls += p; }
    red[tid] = ls; __syncthreads();
    for (int o2 = 128; o2 >= 1; o2 >>= 1) { if (tid < o2) red[tid] += red[tid + o2]; __syncthreads(); }
    const float inv = 1.0f / red[0];
    __syncthreads();
    const int d = tid & 127, half = tid >> 7; float acc = 0.f;
    for (int sgm = half * 2; sgm < half * 2 + 2; ++sgm) {
        const int nb = selb[sgm]; if (nb < 0) continue;
        for (int kk = 0; kk < BLK; ++kk) {
            const float p = sc[sgm * BLK + kk]; if (p == 0.f) continue;
            acc += p * qkv[(size_t)(b * S + nb * BLK + kk) * 3 * D + 2 * D + h * HD + d];
        }
    }
    red[tid] = acc; __syncthreads();
    if (tid < 128) o[(size_t)(b * S + t) * D + h * HD + d] = (red[tid] + red[tid + 128]) * inv;
}

__global__ void __launch_bounds__(256) lru_gates(const float* __restrict__ u, const float* __restrict__ conv_w, const float* __restrict__ conv_b,
                                                 const float* __restrict__ w_a, const float* __restrict__ b_a, const float* __restrict__ w_x,
                                                 const float* __restrict__ b_x, const float* __restrict__ lam, float* __restrict__ a_out,
                                                 float* __restrict__ b_out) {
    __shared__ float xc[DG];
    const int m = blockIdx.x / G, g = blockIdx.x % G, t = m % S, tid = threadIdx.x;
    if (tid < DG) {
        const int ch = g * DG + tid; float s = conv_b[ch];
        for (int tap = 0; tap < 4; ++tap) { const int tt = t - 3 + tap; if (tt >= 0) s += u[(size_t)(m - 3 + tap) * 2 * D + ch] * conv_w[tap * D + ch]; }
        xc[tid] = s;
    }
    __syncthreads();
    if (tid < DG) {
        const int ch = g * DG + tid; float ra = 0.f, rx = 0.f;
        for (int c = 0; c < DG; ++c) { ra += xc[c] * w_a[((size_t)g * DG + c) * DG + tid]; rx += xc[c] * w_x[((size_t)g * DG + c) * DG + tid]; }
        const float r = 1.0f / (1.0f + expf(-(ra + b_a[ch]))), ig = 1.0f / (1.0f + expf(-(rx + b_x[ch])));
        const float nl = -lam[ch]; const float sp = fmaxf(nl, 0.f) + log1pf(expf(-fabsf(nl)));
        const float log_a = -8.0f * r * sp;
        a_out[(size_t)m * D + ch] = expf(log_a);
        b_out[(size_t)m * D + ch] = sqrtf(-expm1f(2.0f * log_a)) * (ig * xc[tid]);
    }
}
__global__ void lru_scan(float* __restrict__ a_io, const float* __restrict__ b_in, const float* __restrict__ u, int NB) {
    const int idx = blockIdx.x * blockDim.x + threadIdx.x; if (idx >= NB * D) return;
    const int b = idx / D, ch = idx % D; float hst = 0.f;
    for (int t = 0; t < S; ++t) {
        const size_t m = (size_t)b * S + t;
        hst = a_io[m * D + ch] * hst + b_in[m * D + ch];
        const float y = u[m * 2 * D + D + ch];
        const float gl = 0.5f * y * (1.0f + tanhf(0.7978845608028654f * (y + 0.044715f * y * y * y)));
        a_io[m * D + ch] = hst * gl;
    }
}

static float* forward(void* const* d_in, int NB, float* hA, float* hB, float* T, float* small, hipStream_t st) {
    const int M = NB * S;
    const float* x = (const float*)d_in[0];
    const float *wqkv = (const float*)d_in[1], *wo = (const float*)d_in[2], *lwin = (const float*)d_in[3], *cw = (const float*)d_in[4], *cb = (const float*)d_in[5],
                *wa = (const float*)d_in[6], *ba = (const float*)d_in[7], *wx = (const float*)d_in[8], *bx = (const float*)d_in[9], *lam = (const float*)d_in[10],
                *lwout = (const float*)d_in[11], *fin = (const float*)d_in[12], *fout = (const float*)d_in[13], *lng = (const float*)d_in[14], *lnb = (const float*)d_in[15];
    const float* h = x; float* bufs[2] = {hA, hB}; int cur = 0;
    const size_t MD = (size_t)M * D;
    for (int i = 0; i < 4; ++i) {
        const int j = i / 2; float* mix;
        if (i % 2 == 0) {
            float* qkv = T; float* o = T + 3 * MD; mix = T;
            gemm<false><<<dim3(3 * D / 64, M / 64), 256, 0, st>>>(h, wqkv + (size_t)j * D * 3 * D, qkv, M, 3 * D, D, 3 * D, 0);
            kmean_k<<<NB * H * NBLK, HD, 0, st>>>(qkv, small);
            attn<<<NB * H * S, 256, 0, st>>>(qkv, small, o);
            gemm<false><<<dim3(D / 64, M / 64), 256, 0, st>>>(o, wo + (size_t)j * D * D, mix, M, D, D, D, 0);
        } else {
            float* u = T; float* av = T + 2 * MD; float* bv = T + 3 * MD; mix = bv;
            gemm<false><<<dim3(2 * D / 64, M / 64), 256, 0, st>>>(h, lwin + (size_t)j * D * 2 * D, u, M, 2 * D, D, 2 * D, 0);
            lru_gates<<<M * G, 128, 0, st>>>(u, cw + (size_t)j * 4 * D, cb + (size_t)j * D, wa + (size_t)j * G * DG * DG, ba + (size_t)j * D, wx + (size_t)j * G * DG * DG,
                                            bx + (size_t)j * D, lam + (size_t)j * D, av, bv);
            lru_scan<<<(NB * D + 255) / 256, 256, 0, st>>>(av, bv, u, NB);
            gemm<false><<<dim3(D / 64, M / 64), 256, 0, st>>>(av, lwout + (size_t)j * D * D, mix, M, D, D, D, 0);
        }
        ln_res<<<M / 4, 256, 0, st>>>(h, mix, lng + (size_t)(i * 2 + 0) * D, lnb + (size_t)(i * 2 + 0) * D, bufs[cur], M);
        h = bufs[cur]; cur ^= 1;
        float* act = T; float* fo = T + 3 * MD;
        gemm<true><<<dim3(F / 64, M / 64), 256, 0, st>>>(h, fin + (size_t)i * D * 2 * F, act, M, F, D, 2 * F, F);
        gemm<false><<<dim3(D / 64, M / 64), 256, 0, st>>>(act, fout + (size_t)i * F * D, fo, M, D, F, D, 0);
        ln_res<<<M / 4, 256, 0, st>>>(h, fo, lng + (size_t)(i * 2 + 1) * D, lnb + (size_t)(i * 2 + 1) * D, bufs[cur], M);
        h = bufs[cur]; cur ^= 1;
    }
    return (float*)h;
}
}

extern "C" void kernel_launch(void* const* d_in, const int* in_sizes, int n_in, void* d_out, int out_size, void* d_ws, size_t ws_size, hipStream_t stream) {
    const size_t MiB = 1u << 20;
    if (ws_size < 322 * MiB) { fprintf(stderr, "ws too small: %zu\n", ws_size); return; }
    char* ws = (char*)d_ws;
    float* hA = (float*)ws; float* T = (float*)(ws + 64 * MiB); float* small = (float*)(ws + 320 * MiB);
    float* res = nv::forward(d_in, 8, hA, (float*)d_out, T, small, stream);
    if (res != (float*)d_out) fprintf(stderr, "result not in d_out!\n");
}
```

```cpp
#include <hip/hip_runtime.h>
#include <hip/hip_cooperative_groups.h>
#include <cstdio>
#include <cstdint>
namespace pg8 {
#define PG8_LAS __attribute__((address_space(3)))
typedef unsigned short bf16_t;
typedef short bf16x8 __attribute__((ext_vector_type(8)));
typedef float f32x4 __attribute__((ext_vector_type(4)));
typedef unsigned u32x4 __attribute__((ext_vector_type(4)));
constexpr int BM = 256, BK = 64, HALF = 128, HTB = HALF * BK * 2  , STAGE_BYTES = 8 * HTB, NXCD = 8, WGM = 8;

__host__ __device__ __forceinline__ int lds_byte(int r, int c) { const int st = (r >> 4) * 2 + (c >> 5), rr = r & 15, cc = c & 31, ob = rr * 64 + cc * 2; return st * 1024 + (ob ^ (((ob >> 9) & 1) << 5)); }
__host__ __device__ __forceinline__ void stage_rc(int b, int& R, int& C) { const int st = b / 1024, sb = b % 1024, swz = sb ^ (((sb >> 9) & 1) << 5); R = (st >> 1) * 16 + swz / 64; C = (st & 1) * 32 + (swz % 64) / 2; }
__host__ __device__ __forceinline__ int perm32(int rho) { const int n = rho >> 4, i = rho & 15; return 8 * (i >> 2) + 4 * n + (i & 3); }

struct Unit { int pm, pn; };
struct Gemm { const bf16_t* A; const bf16_t* Bt; int M, N, K; };

struct StaticOrder {
    int nM, nN, nwg, G, c;
    __host__ __device__ void init(int M, int N, int G_, int c_) { nM = M / BM; nN = N / BM; nwg = nM * nN; G = G_; c = c_; }
    __host__ __device__ bool next(int i, Unit& u) const {
        const long L = (long)i * G + c; if (L >= nwg) return false;
        int wgid = (int)L; { const int q = nwg / NXCD, r = nwg % NXCD, xcd = wgid % NXCD, off = wgid / NXCD; wgid = (xcd < r ? xcd * (q + 1) : r * (q + 1) + (xcd - r) * q) + off; }
        const int nig = WGM * nN, gid = wgid / nig, fm = gid * WGM, gsz = (nM - fm) < WGM ? (nM - fm) : WGM;
        u.pm = fm + ((wgid % nig) % gsz); u.pn = (wgid % nig) / gsz; return true;
    }
    __device__ __forceinline__ void a_ready(const Unit&) const {}
    __device__ __forceinline__ void done(const Unit&) const {}
};
__device__ __forceinline__ unsigned cvt_pk_bf16(float lo, float hi) { unsigned r; asm volatile("v_cvt_pk_bf16_f32 %0, %1, %2" : "=v"(r) : "v"(lo), "v"(hi)); return r; }
typedef float f32x2 __attribute__((ext_vector_type(2)));
typedef unsigned u32x2 __attribute__((ext_vector_type(2)));
constexpr float LN_EPS = 1e-5f, DN_ALPHA = 1.6817928305074290f, LOG2E = 1.4426950408889634f;
__device__ __forceinline__ float fast_sigmoid(float x) { return __builtin_amdgcn_rcpf(1.0f + __builtin_amdgcn_exp2f(-x * LOG2E)); }
__device__ __forceinline__ float gelu_tanh(float y) { const float u = 0.7978845608028654f * (y + 0.044715f * y * y * y); return y * fast_sigmoid(2.0f * u); }
__device__ __forceinline__ void row_mu_rs(const float* st, int row, float& mu, float& rs) {
    if (st == nullptr) { mu = 0.f; rs = 1.f; return; }
    const f32x2 s = *(const f32x2*)(st + 2 * (size_t)row);
    mu = s.x * (1.0f / 1024.0f); const float var = fmaxf(s.y * (1.0f / 1024.0f) - mu * mu, 0.f); rs = __builtin_amdgcn_rsqf(var + LN_EPS);
}

template <int MODE> struct EpiIn {
    static constexpr bool PERM = true, AFTER_DRAIN = false;
    const float* st; const float* cvec; const float* bvec; bf16_t* o0; float* ksum;
    __device__ __forceinline__ void operator()(const f32x4 (&acc)[2][2][4][2], const Unit& u, int wr, int wc, int fr, int fq) const {
        const int row0 = u.pm * BM + wr * 64 + fr, cl = wc * 32 + 8 * fq, colt = u.pn * BM;
        if (MODE == 2) {
#pragma unroll
            for (int n = 0; n < 2; ++n) {
                const f32x4 cg = *(const f32x4*)(cvec + colt + cl + 4 * n), cu = *(const f32x4*)(cvec + colt + HALF + cl + 4 * n);
                const f32x4 bg = *(const f32x4*)(bvec + colt + cl + 4 * n), bu = *(const f32x4*)(bvec + colt + HALF + cl + 4 * n);
#pragma unroll
                for (int ai = 0; ai < 2; ++ai)
#pragma unroll
                    for (int m = 0; m < 4; ++m) {
                        float mu, rs; row_mu_rs(st, row0 + ai * HALF + m * 16, mu, rs);
                        const f32x4 g = (acc[ai][0][m][n] - mu * cg) * rs + bg, uu = (acc[ai][1][m][n] - mu * cu) * rs + bu;
                        float a[4];
#pragma unroll
                        for (int j = 0; j < 4; ++j) a[j] = g[j] * fast_sigmoid(g[j]) * uu[j];
                        u32x2 w; w.x = cvt_pk_bf16(a[0], a[1]); w.y = cvt_pk_bf16(a[2], a[3]);
                        *(u32x2*)(o0 + (size_t)(row0 + ai * HALF + m * 16) * 2816 + u.pn * HALF + cl + 4 * n) = w;
                    }
            }
        } else {
            bf16_t* base; const int ocol = (u.pn & 3) * BM;
            base = o0 + (size_t)(u.pn >> 2) * ((size_t)16384 * 1024);
            const bool is_k = (MODE == 0) && ((u.pn >> 2) == 1), is_gate = (MODE == 1) && (u.pn >= 4);
#pragma unroll
            for (int bj = 0; bj < 2; ++bj) {
                const f32x4 c0 = *(const f32x4*)(cvec + colt + bj * HALF + cl), c1 = *(const f32x4*)(cvec + colt + bj * HALF + cl + 4);
                const f32x4 b0 = *(const f32x4*)(bvec + colt + bj * HALF + cl), b1 = *(const f32x4*)(bvec + colt + bj * HALF + cl + 4);
                f32x4 s0 = {0.f, 0.f, 0.f, 0.f}, s1 = {0.f, 0.f, 0.f, 0.f};
#pragma unroll
                for (int ai = 0; ai < 2; ++ai)
#pragma unroll
                    for (int m = 0; m < 4; ++m) {
                        float mu, rs; row_mu_rs(st, row0 + ai * HALF + m * 16, mu, rs);
                        f32x4 v0 = (acc[ai][bj][m][0] - mu * c0) * rs + b0, v1 = (acc[ai][bj][m][1] - mu * c1) * rs + b1;
                        if (MODE == 0) { s0 += v0; s1 += v1; }
                        if (MODE == 1 && is_gate) {
#pragma unroll
                            for (int j = 0; j < 4; ++j) { v0[j] = gelu_tanh(v0[j]); v1[j] = gelu_tanh(v1[j]); }
                        }
                        u32x4 w; w.x = cvt_pk_bf16(v0[0], v0[1]); w.y = cvt_pk_bf16(v0[2], v0[3]); w.z = cvt_pk_bf16(v1[0], v1[1]); w.w = cvt_pk_bf16(v1[2], v1[3]);
                        *(u32x4*)(base + (size_t)(row0 + ai * HALF + m * 16) * 1024 + ocol + bj * HALF + cl) = w;
                    }
                if (MODE == 0 && is_k) {
                    float t0 = s0[0], t1 = s0[1], t2 = s0[2], t3 = s0[3], t4 = s1[0], t5 = s1[1], t6 = s1[2], t7 = s1[3];
#define RED16(v) v += __shfl_xor(v, 1); v += __shfl_xor(v, 2); v += __shfl_xor(v, 4); v += __shfl_xor(v, 8)
                    RED16(t0); RED16(t1); RED16(t2); RED16(t3); RED16(t4); RED16(t5); RED16(t6); RED16(t7);
#undef RED16
                    if (fr == 0) { float* kp = ksum + (size_t)u.pm * 1024 + ocol + bj * HALF + cl;
                        atomicAdd(kp + 0, t0); atomicAdd(kp + 1, t1); atomicAdd(kp + 2, t2); atomicAdd(kp + 3, t3);
                        atomicAdd(kp + 4, t4); atomicAdd(kp + 5, t5); atomicAdd(kp + 6, t6); atomicAdd(kp + 7, t7); }
                }
            }
        }
    }
};

struct EpiOut {
    static constexpr bool PERM = true, AFTER_DRAIN = false;
    const float* xin; const float* st_in; const float* lg; const float* lb; float* pre; bf16_t* pre16; float* st_out;
    __device__ __forceinline__ void operator()(const f32x4 (&acc)[2][2][4][2], const Unit& u, int wr, int wc, int fr, int fq) const {
        const int row0 = u.pm * BM + wr * 64 + fr, col0 = u.pn * BM + wc * 32 + 8 * fq;
        const bool ln = st_in != nullptr;
        const float* src = ln ? pre : xin;
#pragma unroll
        for (int ai = 0; ai < 2; ++ai)
#pragma unroll
            for (int m = 0; m < 4; ++m) {
                const int row = row0 + ai * HALF + m * 16;
                float mu, rs; row_mu_rs(st_in, row, mu, rs);
                float s = 0.f, q = 0.f;
#pragma unroll
                for (int bj = 0; bj < 2; ++bj) {
                    f32x4 g0 = {1.f, 1.f, 1.f, 1.f}, g1 = g0, b0 = {0.f, 0.f, 0.f, 0.f}, b1 = b0;
                    if (ln) { g0 = *(const f32x4*)(lg + col0 + bj * HALF); g1 = *(const f32x4*)(lg + col0 + bj * HALF + 4); b0 = *(const f32x4*)(lb + col0 + bj * HALF); b1 = *(const f32x4*)(lb + col0 + bj * HALF + 4); }
                    const size_t off = (size_t)row * 1024 + col0 + bj * HALF;
                    const f32x4 p0 = *(const f32x4*)(src + off), p1 = *(const f32x4*)(src + off + 4);
                    const f32x4 v0 = ((p0 - mu) * rs * g0 + b0) * DN_ALPHA + acc[ai][bj][m][0], v1 = ((p1 - mu) * rs * g1 + b1) * DN_ALPHA + acc[ai][bj][m][1];
                    *(f32x4*)(pre + off) = v0; *(f32x4*)(pre + off + 4) = v1;
                    u32x4 w; w.x = cvt_pk_bf16(v0[0], v0[1]); w.y = cvt_pk_bf16(v0[2], v0[3]); w.z = cvt_pk_bf16(v1[0], v1[1]); w.w = cvt_pk_bf16(v1[2], v1[3]);
                    *(u32x4*)(pre16 + off) = w;
                    s += ((v0[0] + v0[1]) + (v0[2] + v0[3])) + ((v1[0] + v1[1]) + (v1[2] + v1[3]));
                    q += ((v0[0] * v0[0] + v0[1] * v0[1]) + (v0[2] * v0[2] + v0[3] * v0[3])) + ((v1[0] * v1[0] + v1[1] * v1[1]) + (v1[2] * v1[2] + v1[3] * v1[3]));
                }
                s += __shfl_xor(s, 16); s += __shfl_xor(s, 32); q += __shfl_xor(q, 16); q += __shfl_xor(q, 32);
                if (fq == 0) { float* sp = st_out + 2 * (size_t)row; atomicAdd(sp, s); atomicAdd(sp + 1, q); }
                asm volatile("" ::: "memory");
            }
    }
};
template <class Epi, class Sched, bool ALIGN_EPI = false, bool SP2 = false>
__device__ __forceinline__ void gemm_phase(PG8_LAS unsigned char* lds, const Gemm g, const Sched& S, const Epi& E) {
    int tid_ = threadIdx.x; asm volatile("" : "+v"(tid_));
    const int tid = tid_, wid = __builtin_amdgcn_readfirstlane(tid >> 6), lane = tid & 63, wr = wid >> 2, wc = wid & 3, fr = lane & 15, fq = lane >> 4;
    const int K = g.K, nt = K / BK;
    unsigned voffA[2], voffB[2];
#pragma unroll
    for (int i = 0; i < 2; ++i) { int R, C; stage_rc(tid * 16 + i * 8192, R, C); const int Rb = Epi::PERM ? ((R & ~31) + perm32(R & 31)) : R;
        voffA[i] = (unsigned)(R * K + C) * 2u; voffB[i] = (unsigned)(Rb * K + C) * 2u; }
    const size_t kstep = (size_t)(BK * 2);
    const size_t hstep = (size_t)HALF * K * 2;
    const size_t tstep = 2 * hstep;
    const unsigned ldsw = (unsigned)wid * 1024u;
    const int aoff = lds_byte(wr * 64 + fr, fq * 8), boff = lds_byte(wc * 32 + fr, fq * 8);
#define PG8_SA(b, h) (((b) * 2 + (h)) * HTB)
#define PG8_SB(b, h) ((4 + (b) * 2 + (h)) * HTB)
#define PG8_STAGE(bufoff, gbase, voff) do { _Pragma("unroll") for (int _i = 0; _i < 2; ++_i) \
        __builtin_amdgcn_global_load_lds((const unsigned*)((const char*)(gbase) + (voff)[_i]), (PG8_LAS unsigned*)(lds + (bufoff) + ldsw + _i * 8192), 16, 0, 0); } while (0)
#define PG8_LDA(dst, b, h) do { _Pragma("unroll") for (int m = 0; m < 4; ++m) _Pragma("unroll") for (int k = 0; k < 2; ++k) dst[m][k] = *(const PG8_LAS bf16x8*)(lds + PG8_SA(b, h) + aoff + m * 2048 + k * 1024); } while (0)
#define PG8_LDB(dst, b, h) do { _Pragma("unroll") for (int n = 0; n < 2; ++n) _Pragma("unroll") for (int k = 0; k < 2; ++k) dst[n][k] = *(const PG8_LAS bf16x8*)(lds + PG8_SB(b, h) + boff + n * 2048 + k * 1024); } while (0)
#define PG8_MMA(ai, bj, At, Bt) do { __builtin_amdgcn_s_setprio(1); _Pragma("unroll") for (int m = 0; m < 4; ++m) _Pragma("unroll") for (int n = 0; n < 2; ++n) _Pragma("unroll") for (int k = 0; k < 2; ++k) \
        acc[ai][bj][m][n] = __builtin_amdgcn_mfma_f32_16x16x32_bf16(Bt[n][k], At[m][k], acc[ai][bj][m][n], 0, 0, 0); __builtin_amdgcn_s_setprio(0); } while (0)
#define PG8_WAIT_V(n) asm volatile("s_waitcnt vmcnt(" #n ")" ::: "memory")
#define PG8_WAIT_L(n) asm volatile("s_waitcnt lgkmcnt(" #n ")" ::: "memory")
#define PG8_BAR __builtin_amdgcn_s_barrier()
#define PG8_SCHED __builtin_amdgcn_sched_barrier(0)
    Unit cur, nxt; int ui = 0;
    if (!S.next(0, cur)) return;
    f32x4 acc[2][2][4][2];
#pragma unroll
    for (int a = 0; a < 2; ++a)
#pragma unroll
        for (int b = 0; b < 2; ++b)
#pragma unroll
            for (int m = 0; m < 4; ++m)
#pragma unroll
                for (int n = 0; n < 2; ++n) acc[a][b][m][n] = (f32x4){0.f, 0.f, 0.f, 0.f};
    bf16x8 At[4][2], B0[2][2], B1[2][2];
    const char* cA = (const char*)g.A + (size_t)cur.pm * tstep; const char* cB = (const char*)g.Bt + (size_t)cur.pn * tstep;
    S.a_ready(cur);
    if constexpr (SP2) {
        PG8_STAGE(PG8_SB(0, 0), cB, voffB); PG8_STAGE(PG8_SB(0, 1), cB + hstep, voffB); PG8_STAGE(PG8_SA(0, 0), cA, voffA); PG8_STAGE(PG8_SA(0, 1), cA + hstep, voffA);
        if (wr == 1) PG8_BAR;
        PG8_WAIT_V(2); PG8_BAR;
        PG8_STAGE(PG8_SB(1, 0), cB + kstep, voffB); PG8_STAGE(PG8_SA(1, 0), cA + kstep, voffA); PG8_STAGE(PG8_SB(1, 1), cB + hstep + kstep, voffB);
        PG8_WAIT_V(6); PG8_BAR;
    } else {
        PG8_STAGE(PG8_SB(0, 0), cB, voffB); PG8_STAGE(PG8_SA(0, 0), cA, voffA); PG8_STAGE(PG8_SB(0, 1), cB + hstep, voffB); PG8_STAGE(PG8_SA(0, 1), cA + hstep, voffA);
        if (wr == 1) PG8_BAR;
        PG8_WAIT_V(4); PG8_BAR;
        PG8_STAGE(PG8_SB(1, 0), cB + kstep, voffB); PG8_STAGE(PG8_SA(1, 0), cA + kstep, voffA); PG8_STAGE(PG8_SB(1, 1), cB + hstep + kstep, voffB);
        PG8_WAIT_V(6); PG8_BAR;
    }
    for (;;) {
        const bool has_next = S.next(ui + 1, nxt);
        const char* nA = has_next ? (const char*)g.A + (size_t)nxt.pm * tstep : cA; const char* nB = has_next ? (const char*)g.Bt + (size_t)nxt.pn * tstep : cB;
        for (int t = 0; t < nt; t += 2) {
            const bool last = (t == nt - 2);
            const char* a1 = cA + (size_t)(t + 1) * kstep;
            const char* a2 = last ? nA : cA + (size_t)(t + 2) * kstep; const char* b2 = last ? nB : cB + (size_t)(t + 2) * kstep;
            const char* a3 = a2 + kstep; const char* b3 = b2 + kstep;
            if (last && has_next) S.a_ready(nxt);
            if constexpr (SP2) {
            PG8_LDB(B0, 0, 0); PG8_LDB(B1, 0, 1); PG8_SCHED; PG8_LDA(At, 0, 0); PG8_STAGE(PG8_SA(1, 1), a1 + hstep, voffA);
            PG8_WAIT_V(8); PG8_WAIT_L(0); PG8_BAR; PG8_MMA(0, 0, At, B0); PG8_MMA(0, 1, At, B1); PG8_BAR; PG8_SCHED;
            PG8_LDA(At, 0, 1); PG8_STAGE(PG8_SB(0, 0), b2, voffB); PG8_STAGE(PG8_SB(0, 1), b2 + hstep, voffB); PG8_STAGE(PG8_SA(0, 0), a2, voffA);
            PG8_WAIT_V(8); PG8_WAIT_L(0); PG8_BAR; PG8_MMA(1, 0, At, B0); PG8_MMA(1, 1, At, B1); PG8_BAR; PG8_SCHED;
            PG8_LDB(B0, 1, 0); PG8_LDB(B1, 1, 1); PG8_SCHED; PG8_LDA(At, 1, 0); PG8_STAGE(PG8_SA(0, 1), a2 + hstep, voffA);
            PG8_WAIT_V(8); PG8_WAIT_L(0); PG8_BAR; PG8_MMA(0, 0, At, B0); PG8_MMA(0, 1, At, B1); PG8_BAR; PG8_SCHED;
            PG8_LDA(At, 1, 1); PG8_STAGE(PG8_SB(1, 0), b3, voffB); PG8_STAGE(PG8_SB(1, 1), b3 + hstep, voffB); PG8_STAGE(PG8_SA(1, 0), a3, voffA);
            PG8_WAIT_V(8); PG8_WAIT_L(0); PG8_BAR; PG8_MMA(1, 0, At, B0); PG8_MMA(1, 1, At, B1); PG8_BAR; PG8_SCHED;
            } else {
            PG8_LDB(B0, 0, 0); PG8_SCHED; PG8_LDA(At, 0, 0); PG8_STAGE(PG8_SA(1, 1), a1 + hstep, voffA);
            PG8_WAIT_L(8); PG8_BAR; PG8_WAIT_L(0); PG8_MMA(0, 0, At, B0); PG8_BAR; PG8_SCHED;
            PG8_LDB(B1, 0, 1); PG8_STAGE(PG8_SB(0, 0), b2, voffB);
            PG8_BAR; PG8_WAIT_L(0); PG8_MMA(0, 1, At, B1); PG8_BAR;
            PG8_LDA(At, 0, 1); PG8_STAGE(PG8_SA(0, 0), a2, voffA);
            PG8_BAR; PG8_WAIT_L(0); PG8_MMA(1, 0, At, B0); PG8_BAR; PG8_SCHED;
            PG8_STAGE(PG8_SB(0, 1), b2 + hstep, voffB);
            PG8_WAIT_V(6); PG8_BAR; PG8_MMA(1, 1, At, B1); PG8_BAR;
            PG8_LDB(B0, 1, 0); PG8_SCHED; PG8_LDA(At, 1, 0); PG8_STAGE(PG8_SA(0, 1), a2 + hstep, voffA);
            PG8_WAIT_L(8); PG8_BAR; PG8_WAIT_L(0); PG8_MMA(0, 0, At, B0); PG8_BAR; PG8_SCHED;
            PG8_LDB(B1, 1, 1); PG8_STAGE(PG8_SB(1, 0), b3, voffB);
            PG8_BAR; PG8_WAIT_L(0); PG8_MMA(0, 1, At, B1); PG8_BAR;
            PG8_LDA(At, 1, 1); PG8_STAGE(PG8_SA(1, 0), a3, voffA);
            PG8_BAR; PG8_WAIT_L(0); PG8_MMA(1, 0, At, B0); PG8_BAR; PG8_SCHED;
            PG8_STAGE(PG8_SB(1, 1), b3 + hstep, voffB);
            PG8_WAIT_V(6); PG8_BAR; PG8_MMA(1, 1, At, B1); PG8_BAR;
            }
        }
        if constexpr (ALIGN_EPI) { if (wr == 0) PG8_BAR; }
        if constexpr (!Epi::AFTER_DRAIN) { E(acc, cur, wr, wc, fr, fq); S.done(cur); }
        if (!has_next) break;
#pragma unroll
        for (int a = 0; a < 2; ++a)
#pragma unroll
            for (int b = 0; b < 2; ++b)
#pragma unroll
                for (int m = 0; m < 4; ++m)
#pragma unroll
                    for (int n = 0; n < 2; ++n) acc[a][b][m][n] = (f32x4){0.f, 0.f, 0.f, 0.f};
        cur = nxt; cA = nA; cB = nB; ++ui;
        if constexpr (ALIGN_EPI) { if (wr == 1) PG8_BAR; }
    }
    PG8_WAIT_V(0);
    if constexpr (!ALIGN_EPI) { if (wr == 0) PG8_BAR; }
    PG8_BAR;
    if constexpr (Epi::AFTER_DRAIN) { E.fused(acc, cur, wr, wc, fr, fq, lds, wid, lane); S.done(cur); }
#undef PG8_SA
#undef PG8_SB
#undef PG8_STAGE
#undef PG8_LDA
#undef PG8_LDB
#undef PG8_MMA
#undef PG8_WAIT_V
#undef PG8_WAIT_L
#undef PG8_BAR
#undef PG8_SCHED
}
}
namespace moba {
typedef unsigned short bf16;
typedef short bf16x8 __attribute__((ext_vector_type(8)));
typedef short s16x4 __attribute__((ext_vector_type(4)));
typedef float f32x16 __attribute__((ext_vector_type(16)));
typedef float f32x4 __attribute__((ext_vector_type(4)));
typedef unsigned u32x4 __attribute__((ext_vector_type(4)));
constexpr int D = 128, RS = 1024;
constexpr float SCALE = 0.08838834764831845f;
constexpr float THR = 8.f;
constexpr int NW = 8, QBLK = 32, KVBLK = 64, QB = NW * QBLK;
constexpr int SHM_V = KVBLK * D * 2, SHM_K = KVBLK * D * 2;
constexpr int KM_OFF = 2 * SHM_V + 2 * SHM_K + NW * 64 * 4;
constexpr int LDS_BYTES = KM_OFF + 8 * 128 * 4;

#define KSWZ(row, colB) ((row) * 256 + ((colB) ^ (((row) & 7) << 4)))
#define SBAR() __builtin_amdgcn_sched_barrier(0)
__device__ __forceinline__ int v_st(int k, int c) { const int kk = (k & ~0xC) | ((k & 4) << 1) | ((k & 8) >> 1); return ((kk >> 3) * 4 + (c >> 5)) * 512 + ((kk & 7) * 32 + (c & 31)) * 2; }
__device__ __forceinline__ int v_rd_base(int lane) { return ((lane & 3) << 3) | (((lane >> 2) & 3) << 6) | (((lane >> 4) & 1) << 5) | (((lane >> 5) & 1) << 8); }
constexpr int v_rd_off(int d0, int ks, int half) { return d0 * 512 + ks * 4096 + half * 2048; }
__device__ __forceinline__ int crow(int r, int hi) { return (r & 3) + 8 * (r >> 2) + 4 * hi; }
__device__ __forceinline__ unsigned cvtpk(float lo, float hi) {
    unsigned r; asm volatile("v_cvt_pk_bf16_f32 %0, %1, %2" : "=v"(r) : "v"(lo), "v"(hi)); return r;
}
__device__ __forceinline__ bf16x8 load8(const bf16* p) { return *reinterpret_cast<const bf16x8*>(p); }
__device__ __forceinline__ void mask_tile(f32x16& p0, f32x16& p1, int dq) {
    const float NEG = -__builtin_inff();
#pragma unroll
    for (int r = 0; r < 16; ++r) {
        const int c = (r & 3) + 8 * (r >> 2);
        if (dq - c < 0) p0[r] = NEG;
        if (dq - c - 32 < 0) p1[r] = NEG;
    }
}
__device__ __forceinline__ void partialSM(f32x16& p0, f32x16& p1, float& m_reg, float& mn, float& alpha) {
    float pmax = p0[0];
    _Pragma("unroll") for (int r = 1; r < 16; ++r) pmax = fmaxf(pmax, p0[r]);
    _Pragma("unroll") for (int r = 0; r < 16; ++r) pmax = fmaxf(pmax, p1[r]);
    { auto rr = __builtin_amdgcn_permlane32_swap(__float_as_uint(pmax), __float_as_uint(pmax), false, false);
      pmax = fmaxf(__uint_as_float(rr[0]), __uint_as_float(rr[1])); }
    constexpr float C2 = 1.4426950408889634f * SCALE;
    if (__builtin_expect(__all((pmax - m_reg) * SCALE <= THR), 1)) { mn = m_reg; alpha = 1.f; }
    else { mn = fmaxf(m_reg, pmax); alpha = __builtin_amdgcn_exp2f((m_reg - mn) * C2); m_reg = mn; }
    const float mnL = -mn * C2;
    _Pragma("unroll") for (int r = 0; r < 16; ++r) p0[r] = fmaf(p0[r], C2, mnL);
    _Pragma("unroll") for (int r = 0; r < 16; ++r) p1[r] = fmaf(p1[r], C2, mnL);
    _Pragma("unroll") for (int r = 0; r < 16; ++r) p0[r] = __builtin_amdgcn_exp2f(p0[r]);
}
__device__ __forceinline__ void finishSM(f32x16& p0, f32x16& p1, float alpha, float& l_reg, bf16x8& pa0, bf16x8& pa1, bf16x8& pa2, bf16x8& pa3) {
    _Pragma("unroll") for (int r = 0; r < 16; ++r) p1[r] = __builtin_amdgcn_exp2f(p1[r]);
    float ps = 0;
    _Pragma("unroll") for (int r = 0; r < 16; ++r) ps += p0[r];
    _Pragma("unroll") for (int r = 0; r < 16; ++r) ps += p1[r];
    { auto rr = __builtin_amdgcn_permlane32_swap(__float_as_uint(ps), __float_as_uint(ps), false, false);
      ps = __uint_as_float(rr[0]) + __uint_as_float(rr[1]); }
    l_reg = l_reg * alpha + ps;
#define PK4(P, B_, OUT) do { unsigned a0 = cvtpk(P[B_+0], P[B_+1]), a1 = cvtpk(P[B_+2], P[B_+3]);                          \
        unsigned b0 = cvtpk(P[B_+4], P[B_+5]), b1 = cvtpk(P[B_+6], P[B_+7]);                                             \
        auto r0 = __builtin_amdgcn_permlane32_swap(a0, b0, false, false); auto r1 = __builtin_amdgcn_permlane32_swap(a1, b1, false, false); \
        u32x4 w = {r0[0], r1[0], r0[1], r1[1]}; OUT = *reinterpret_cast<bf16x8*>(&w); } while (0)
    PK4(p0, 0, pa0); PK4(p0, 8, pa1); PK4(p1, 0, pa2); PK4(p1, 8, pa3);
#undef PK4
}
template <int KB>
__device__ __forceinline__ void qkt(f32x16& p0, f32x16& p1, const char* K_lds, int r32, int hi, const bf16x8* qr, float b0, const float (&ksm)[5]) {
    { const float bc0 = b0, bc1 = bc0 + ksm[0], bc2 = bc1 + ksm[0], bc3 = bc2 + ksm[0];
      p0[0] = bc0; p0[1] = bc1; p0[2] = bc2; p0[3] = bc3;
#pragma unroll
      for (int g = 1; g < 4; ++g) { p0[4 * g + 0] = bc0 + ksm[g]; p0[4 * g + 1] = bc1 + ksm[g]; p0[4 * g + 2] = bc2 + ksm[g]; p0[4 * g + 3] = bc3 + ksm[g]; }
#pragma unroll
      for (int r = 0; r < 16; ++r) p1[r] = p0[r] + ksm[4]; }
    const char* kb[4];
#pragma unroll
    for (int dd = 0; dd < 4; ++dd) kb[dd] = K_lds + KB * SHM_K + KSWZ(r32, (dd * 16 + hi * 8) * 2);
#pragma unroll
    for (int d0 = 0; d0 < 8; ++d0) { const char* a = kb[d0 & 3] + (d0 >> 2) * 128;
        bf16x8 b0v = *reinterpret_cast<const bf16x8*>(a);
        bf16x8 b1v = *reinterpret_cast<const bf16x8*>(a + 32 * 256);
        p0 = __builtin_amdgcn_mfma_f32_32x32x16_bf16(b0v, qr[d0], p0, 0, 0, 0);
        p1 = __builtin_amdgcn_mfma_f32_32x32x16_bf16(b1v, qr[d0], p1, 0, 0, 0); }
}
template <int VB>
__device__ __forceinline__ void pv_tile(f32x16* o, int vb0, bf16x8 pa0, bf16x8 pa1, bf16x8 pa2, bf16x8 pa3) {
#define TRRD(dst, off) asm volatile("ds_read_b64_tr_b16 %0, %1 offset:%2" : "=&v"(dst) : "v"(vb0), "i"(off) : "memory")
#define PV_D0(d0) do { s16x4 l0, l1, l2, l3, h0, h1, h2, h3; constexpr int b_ = VB * SHM_V + v_rd_off(d0, 0, 0);     \
        TRRD(l0, b_); TRRD(h0, b_ + 2048); TRRD(l1, b_ + 4096); TRRD(h1, b_ + 6144); TRRD(l2, b_ + 8192); TRRD(h2, b_ + 10240); TRRD(l3, b_ + 12288); TRRD(h3, b_ + 14336); \
        asm volatile("s_waitcnt lgkmcnt(0)" ::: "memory"); SBAR();                 \
        o[d0] = __builtin_amdgcn_mfma_f32_32x32x16_bf16(pa0, (bf16x8){l0[0], l0[1], l0[2], l0[3], h0[0], h0[1], h0[2], h0[3]}, o[d0], 0, 0, 0);   \
        o[d0] = __builtin_amdgcn_mfma_f32_32x32x16_bf16(pa1, (bf16x8){l1[0], l1[1], l1[2], l1[3], h1[0], h1[1], h1[2], h1[3]}, o[d0], 0, 0, 0);   \
        o[d0] = __builtin_amdgcn_mfma_f32_32x32x16_bf16(pa2, (bf16x8){l2[0], l2[1], l2[2], l2[3], h2[0], h2[1], h2[2], h2[3]}, o[d0], 0, 0, 0);   \
        o[d0] = __builtin_amdgcn_mfma_f32_32x32x16_bf16(pa3, (bf16x8){l3[0], l3[1], l3[2], l3[3], h3[0], h3[1], h3[2], h3[3]}, o[d0], 0, 0, 0); } while (0)
    PV_D0(0); PV_D0(1); PV_D0(2); PV_D0(3);
#undef PV_D0
#undef TRRD
}

struct BlockRef { const bf16* Q; const bf16* K; const bf16* V; bf16* O; const float* KM; int qb; float ks; };
struct Seam { bf16x8 qr[8]; bf16x8 st_v0, st_v1, st_k0, st_k1; };
#define ROW(p, k0, rr) ((p) + (size_t)((k0) + (rr)) * RS + sc)
#define VMW() asm volatile("s_waitcnt vmcnt(0)" ::: "memory")
#define VMWN(n) asm volatile("s_waitcnt vmcnt(%0)" :: "i"(n) : "memory")
#define SLOAD_H(Kp, Vp, k0) do { S.st_v0 = load8(ROW(Vp, k0, sr)); S.st_v1 = load8(ROW(Vp, k0, 32 + sr));              \
                         S.st_k0 = load8(ROW(Kp, k0, sr)); S.st_k1 = load8(ROW(Kp, k0, 32 + sr)); } while (0)
#define SWRITE_HK(bf) do { *(bf16x8*)(K_lds + (bf) * SHM_K + kws) = S.st_k0; *(bf16x8*)(K_lds + (bf) * SHM_K + kws + 32 * 256) = S.st_k1; } while (0)
#define SWRITE_HV(bf) do { *(bf16x8*)(V_lds + (bf) * SHM_V + vst0) = S.st_v0; *(bf16x8*)(V_lds + (bf) * SHM_V + vst1) = S.st_v1; } while (0)
#define SWRITE_H(bf) do { SWRITE_HV(bf); SWRITE_HK(bf); } while (0)
__device__ __forceinline__ void moba_prime(const BlockRef& cur, char* lds, Seam& S) {
    int tid_ = threadIdx.x; asm volatile("" : "+v"(tid_));
    const int tid = tid_, wid = __builtin_amdgcn_readfirstlane(tid >> 6), lane = tid & 63, r32 = lane & 31, hi = lane >> 5;
    const int sr = tid >> 4, sc = (tid & 15) * 8, kws = KSWZ(sr, sc * 2); char* K_lds = lds + 2 * SHM_V;
    _Pragma("unroll") for (int d0 = 0; d0 < 8; ++d0) S.qr[d0] = load8(cur.Q + (size_t)(wid * QBLK + r32) * RS + d0 * 16 + hi * 8);
    SLOAD_H(cur.K, cur.V, 0); VMW(); SWRITE_HK(0);
    __syncthreads();
}
__device__ __forceinline__ void moba_block(const BlockRef& cur, const BlockRef& nxt, char* lds, Seam& S) {
    int tid_ = threadIdx.x; asm volatile("" : "+v"(tid_));
    const int tid = tid_, wid = __builtin_amdgcn_readfirstlane(tid >> 6), lane = tid & 63, r32 = lane & 31, hi = lane >> 5;
    const int qb = cur.qb, P0 = qb * QB;
    const int NT = 4 * (qb + 1);
    const int qlo = P0 + wid * QBLK, qm = qlo + r32 - 4 * hi;
    char* V_lds = lds; char* K_lds = lds + 2 * SHM_V;
    float* ws = (float*)(lds + 2 * SHM_V + 2 * SHM_K) + wid * 64; float* li_l = ws, * al_l = ws + 32;
    float* KM = (float*)(lds + KM_OFF);
    if (tid < 256) *(f32x4*)(KM + tid * 4) = *(const f32x4*)(cur.KM + (size_t)(tid >> 5) * 1024 + (tid & 31) * 4);
    __syncthreads();
    unsigned selmask;
    {
        float g[7];
#pragma unroll
        for (int n = 0; n < 7; ++n) g[n] = 0.f;
#pragma unroll
        for (int d0 = 0; d0 < 8; ++d0) {
            float qf[8];
#pragma unroll
            for (int j = 0; j < 8; ++j) qf[j] = __uint_as_float(((unsigned)(unsigned short)S.qr[d0][j]) << 16);
#pragma unroll
            for (int n = 0; n < 7; ++n) if (n < qb) {
                const f32x4 k0 = *(const f32x4*)(KM + n * 128 + d0 * 16 + hi * 8), k1 = *(const f32x4*)(KM + n * 128 + d0 * 16 + hi * 8 + 4);
                g[n] += (qf[0] * k0[0] + qf[1] * k0[1]) + (qf[2] * k0[2] + qf[3] * k0[3]) + (qf[4] * k1[0] + qf[5] * k1[1]) + (qf[6] * k1[2] + qf[7] * k1[3]);
            }
        }
#pragma unroll
        for (int n = 0; n < 7; ++n) g[n] += __shfl_xor(g[n], 32);
        if (qb <= 3) selmask = (1u << qb) - 1u;
        else {
            selmask = 0u;
#pragma unroll
            for (int k = 0; k < 3; ++k) {
                int best = 0; float bv = -__builtin_inff();
#pragma unroll
                for (int n = 0; n < 7; ++n) if (n < qb && !((selmask >> n) & 1u) && g[n] > bv) { bv = g[n]; best = n; }
                selmask |= 1u << best;
            }
        }
        selmask |= 1u << qb;
    }
    const float NEGINF = -__builtin_inff();
    float ksm[5];
    { const float k_ = cur.ks; const float mul[5] = {1.f, 8.f, 16.f, 24.f, 32.f};
#pragma unroll
      for (int i = 0; i < 5; ++i) ksm[i] = __uint_as_float(__builtin_amdgcn_readfirstlane(__float_as_uint(k_ * mul[i]))); }
    const float ks = ksm[0];
    float m_reg = -1e30f, l_reg = 0; f32x16 o[4] = {};
    const int sr = tid >> 4, sc = (tid & 15) * 8, vst0 = v_st(sr, sc), vst1 = v_st(32 + sr, sc), kws = KSWZ(sr, sc * 2);
    const int vb0 = (int)(uintptr_t)V_lds + v_rd_base(lane);
    const bf16* Kh = cur.K; const bf16* Vh = cur.V;
#define RESC(a) do { if (__any((a) < 1.f)) { if (hi == 0) al_l[r32] = (a); asm volatile("s_waitcnt lgkmcnt(0)" ::: "memory");              \
                     _Pragma("unroll") for (int d_ = 0; d_ < 4; ++d_) _Pragma("unroll") for (int r = 0; r < 16; ++r) o[d_][r] *= al_l[crow(r, hi)]; } } while (0)
#define KBASE(t) ((t) * KVBLK)
#define B0(t) ((((selmask >> ((t) >> 2)) & 1u) != 0u) ? -ks * (float)(qm - KBASE(t)) : NEGINF)
#define MASKT(P0_, P1_, t) do { const int kb_ = KBASE(t); if (kb_ + KVBLK - 1 > qlo) mask_tile(P0_, P1_, qm - kb_); } while (0)
#define SEAM_K0() do { VMWN(8); SWRITE_HK(0); SBAR(); } while (0)
    f32x16 pA0, pA1, pB0, pB1; float mnA, mnB, alA, alB; bf16x8 pa0, pa1, pa2, pa3;
    SWRITE_HV(0); SBAR();
    SLOAD_H(Kh, Vh, KBASE(1));
    SBAR(); qkt<0>(pA0, pA1, K_lds, r32, hi, S.qr, B0(0), ksm);
    MASKT(pA0, pA1, 0); partialSM(pA0, pA1, m_reg, mnA, alA);
    VMW(); SWRITE_H(1);
    __syncthreads();
#define HALF_STEP(PX0, PX1, mnX, alX, PY0, PY1, alY, t, KB, VB, SB) do {                                                      \
        SBAR(); qkt<KB>(PX0, PX1, K_lds, r32, hi, S.qr, B0(t), ksm);                                                           \
        finishSM(PY0, PY1, alY, l_reg, pa0, pa1, pa2, pa3); SBAR();                                                           \
        if ((t) + 1 < NT) { SLOAD_H(Kh, Vh, KBASE((t) + 1)); SBAR(); }                                                        \
        pv_tile<VB>(o, vb0, pa0, pa1, pa2, pa3); MASKT(PX0, PX1, (t)); partialSM(PX0, PX1, m_reg, mnX, alX);                  \
        __syncthreads();                                                                                                      \
        if ((t) + 1 < NT) { VMW(); SWRITE_H(SB); }                                                                            \
        RESC(alX); __syncthreads(); } while (0)
    for (int t = 1; t + 1 < NT; t += 2) {
        HALF_STEP(pB0, pB1, mnB, alB, pA0, pA1, alA, t, 1, 0, 0);
        HALF_STEP(pA0, pA1, mnA, alA, pB0, pB1, alB, t + 1, 0, 1, 1);
    }
    SBAR(); qkt<1>(pB0, pB1, K_lds, r32, hi, S.qr, B0(NT - 1), ksm); SBAR();
    SLOAD_H(nxt.K, nxt.V, 0); SBAR();
#pragma unroll
    for (int d0 = 0; d0 < 8; ++d0) S.qr[d0] = load8(nxt.Q + (size_t)(wid * QBLK + r32) * RS + d0 * 16 + hi * 8);
    SBAR();
    finishSM(pA0, pA1, alA, l_reg, pa0, pa1, pa2, pa3); SBAR();
    pv_tile<0>(o, vb0, pa0, pa1, pa2, pa3);
    MASKT(pB0, pB1, NT - 1); partialSM(pB0, pB1, m_reg, mnB, alB); __syncthreads(); RESC(alB);
    finishSM(pB0, pB1, alB, l_reg, pa0, pa1, pa2, pa3); SBAR(); pv_tile<1>(o, vb0, pa0, pa1, pa2, pa3);
    SBAR(); SEAM_K0();
    if (hi == 0) li_l[r32] = l_reg; asm volatile("s_waitcnt lgkmcnt(0)" ::: "memory");
    float rli[16];
#pragma unroll
    for (int r = 0; r < 16; ++r) rli[r] = __builtin_amdgcn_rcpf(li_l[crow(r, hi)]);
    bf16* Ow = cur.O + (size_t)(wid * QBLK) * RS;
#pragma unroll
    for (int r = 0; r < 16; ++r) { const int orow = crow(r, hi);
#pragma unroll
        for (int d0 = 0; d0 < 4; ++d0) { const float v = o[d0][r] * rli[r];
            const float vn = __shfl_xor(v, 1);
            if ((r32 & 1) == 0) *(unsigned*)(Ow + (size_t)orow * RS + d0 * 32 + r32) = cvtpk(v, vn); } }
    __syncthreads();
#undef RESC
#undef KBASE
#undef B0
#undef MASKT
#undef SEAM_K0
#undef HALF_STEP
}
#undef ROW
#undef VMW
#undef VMWN
#undef SLOAD_H
#undef SWRITE_HK
#undef SWRITE_HV
#undef SWRITE_H
#undef KSWZ
#undef SBAR
}
#define GAS __attribute__((address_space(1)))
#define LAS __attribute__((address_space(3)))
typedef unsigned short bf16;
typedef unsigned v4u __attribute__((ext_vector_type(4)));
typedef float f32x4 __attribute__((ext_vector_type(4)));
typedef short bf16x8 __attribute__((ext_vector_type(8)));
typedef GAS unsigned gu32;
typedef GAS unsigned long long gu64;
#define RLX_AGENT __ATOMIC_RELAXED, __HIP_MEMORY_SCOPE_AGENT
#define LDS_WAIT() asm volatile("s_waitcnt lgkmcnt(0)" ::: "memory")
#define VM_WAIT() asm volatile("s_waitcnt vmcnt(0)" ::: "memory")
__device__ __forceinline__ unsigned long long rt() { return __builtin_amdgcn_s_memrealtime(); }
__device__ __forceinline__ unsigned f2bf(float f) { unsigned u = __builtin_bit_cast(unsigned, f); return (u + 0x7fffu + ((u >> 16) & 1u)) >> 16; }
__device__ __forceinline__ unsigned pk2(float lo, float hi) { return f2bf(lo) | (f2bf(hi) << 16); }

#define XB_TMO      128
#define XB_XCNT(j)  (256  + 64 * (j))
#define XB_XSUB(j)  (1280 + 64 * (j))
#define XB_XGEN(j)  (2304 + 64 * (j))
#define XB_TOP      3328
#define XB_TOPGEN   3392
#define XCD_BAR_WORDS 3456
#define XB_SPIN_CAP (1u << 18)

__device__ __forceinline__ unsigned xb_ld(unsigned* p)              { return __hip_atomic_load(p, __ATOMIC_RELAXED, __HIP_MEMORY_SCOPE_AGENT); }
__device__ __forceinline__ unsigned xb_add(unsigned* p, unsigned v) { return __hip_atomic_fetch_add(p, v, __ATOMIC_RELAXED, __HIP_MEMORY_SCOPE_AGENT); }
__device__ __forceinline__ unsigned xb_xcc_id() { return (unsigned)__builtin_amdgcn_s_getreg((3 << 11) | 20) & 0xFu; }
#define XB_SPIN(cond, bar) do { unsigned _sp = 0; while (cond) { __builtin_amdgcn_s_sleep(1); \
    if ((++_sp & 255u) == 0u) { if (xb_ld(&(bar)[XB_TMO])) break; if (_sp > XB_SPIN_CAP) { atomicAdd(&(bar)[XB_TMO], 1u); break; } } } } while (0)

struct XcdBarrier {
    unsigned* bar; unsigned x;
    volatile LAS unsigned* st;
};

__device__ __forceinline__ XcdBarrier xcd_barrier_post(unsigned* bar, volatile LAS unsigned* st) {
    XcdBarrier b; b.bar = bar; b.x = xb_xcc_id(); b.st = st;
    if (threadIdx.x == 0) (void)xb_add(&bar[XB_XCNT(b.x)], 1u);
    return b;
}
__device__ __forceinline__ void xcd_barrier_complete(unsigned* bar, unsigned x, unsigned& nloc, unsigned& nx) {
    const unsigned G = gridDim.x * gridDim.y * gridDim.z;
    unsigned sum, cnt, mine, sp = 0u;
    for (;;) {
        sum = 0u; cnt = 0u; mine = 0u;
#pragma unroll
        for (unsigned j = 0; j < 16; ++j) { const unsigned c = xb_ld(&bar[XB_XCNT(j)]); sum += c; cnt += (c > 0u) ? 1u : 0u; mine = (j == x) ? c : mine; }
        if (sum == G) break;
        __builtin_amdgcn_s_sleep(1);
        if ((++sp & 255u) == 0u) { if (xb_ld(&bar[XB_TMO])) break; if (sp > XB_SPIN_CAP) { atomicAdd(&bar[XB_TMO], 1u); break; } }
    }
    nloc = mine > 0u ? mine : 1u; nx = cnt > 0u ? cnt : 1u;
}

__device__ __forceinline__ void xcd_barrier(const XcdBarrier& b) {
    asm volatile("s_waitcnt vmcnt(0)" ::: "memory");
    __syncthreads();
    if (threadIdx.x == 0) {
        unsigned* bar = b.bar;
        __builtin_amdgcn_s_waitcnt(0);
        unsigned nloc = b.st[0], nx = b.st[1];
        if (nloc == 0u) { xcd_barrier_complete(bar, b.x, nloc, nx); b.st[0] = nloc; b.st[1] = nx; }
        const unsigned old = xb_add(&bar[XB_XSUB(b.x)], 1u);
        const unsigned gen = old / nloc;
        if (old + 1u == (gen + 1u) * nloc) {
            __builtin_amdgcn_fence(__ATOMIC_RELEASE, "agent");
            asm volatile("s_waitcnt vmcnt(0)" ::: "memory");
            const unsigned og = xb_add(&bar[XB_TOP], 1u);
            const unsigned tg = og / nx;
            if (og + 1u == (tg + 1u) * nx) xb_add(&bar[XB_TOPGEN], 1u);
            else XB_SPIN(xb_ld(&bar[XB_TOPGEN]) == tg, bar);
            __builtin_amdgcn_fence(__ATOMIC_ACQUIRE, "agent");
            xb_add(&bar[XB_XGEN(b.x)], 1u);
            asm volatile("s_waitcnt vmcnt(0)" ::: "memory");
        } else {
            XB_SPIN(xb_ld(&bar[XB_XGEN(b.x)]) == gen, bar);
            __builtin_amdgcn_fence(__ATOMIC_ACQUIRE, "agent");
            asm volatile("s_waitcnt vmcnt(0)" ::: "memory");
        }
    }
    __syncthreads();
}
typedef float f32x2v __attribute__((ext_vector_type(2)));
constexpr int NWAVES = 8;
constexpr int BATCH = 8, SEQ = 2048, DM = 1024, NH = 8, FF = 2816, DEPTH = 4;
constexpr int M = BATCH * SEQ;
constexpr size_t MiB = 1u << 20;
constexpr size_t WS_CTL = 0;
constexpr size_t WS_STATS = 1 * MiB;
constexpr size_t WS_KSUM = 2 * MiB;
constexpr size_t WS_VEC = 3 * MiB;
constexpr size_t ZERO_BYTES = 4 * MiB;
constexpr int V_QKV = 0, V_LIN = 2 * 3072, V_FIN = V_LIN + 2 * 2048, V_TOTAL = V_FIN + 4 * 5632;
constexpr size_t WS_W = 8 * MiB;
constexpr size_t W_QKV = 0, W_WO = W_QKV + 2ull * 3072 * 1024, W_LIN = W_WO + 2ull * 1024 * 1024, W_LOUT = W_LIN + 2ull * 2048 * 1024,
                 W_FIN = W_LOUT + 2ull * 1024 * 1024, W_FOUT = W_FIN + 4ull * 5632 * 1024, W_GA = W_FOUT + 4ull * 1024 * 2816, W_GX = W_GA + 2ull * 8 * 128 * 128,
                 W_END = W_GX + 2ull * 8 * 128 * 128;
constexpr size_t WS_XB16 = 104 * MiB;
constexpr size_t WS_T = 136 * MiB;
constexpr size_t WS_END = 264 * MiB;
static_assert(WS_W + W_END * 2 <= WS_XB16, "weights fit");
constexpr int CW_BAR = 1024;

constexpr int RING_OFF = 0, RING_BYTES = 131072;
constexpr int LDSCTL_OFF = RING_BYTES, MISC_OFF = LDSCTL_OFF + 320;
constexpr int LDS_BYTES = 147456;

__device__ __forceinline__ float bf2f(unsigned short b) { return __uint_as_float(((unsigned)b) << 16); }
__device__ __forceinline__ float wave_sum(float v) {
#pragma unroll
    for (int o = 1; o < 64; o <<= 1) v += __shfl_xor(v, o);
    return v;
}

__device__ __forceinline__ int dest_col(int n, int perm) { if (!perm) return n; const int j = n < FF ? n : n - FF; return 256 * (j >> 7) + (n < FF ? 0 : 128) + (j & 127); }
__device__ __forceinline__ void p0_item(const float* W, int K, int N, bf16* WT, const float* gain, const float* lbias, float* cvec, float* bvec, int perm,
                                        LAS float* scr, int item, int lane) {
    const int nblk = N / 32, kb = item / nblk, nb = item % nblk, k0 = 64 * kb, n0 = 32 * nb;
    float cs = 0.f, bs = 0.f;
#pragma unroll 8
    for (int i = 0; i < 32; ++i) { const int kk = 2 * i + (lane >> 5);
        const float w = W[(size_t)(k0 + kk) * N + n0 + (lane & 31)]; const float gw = gain ? w * gain[k0 + kk] : w;
        scr[kk * 33 + (lane & 31)] = gw;
        if (cvec) { cs += bf2f((unsigned short)f2bf(gw)); bs += lbias[k0 + kk] * w; } }
    if (cvec) { cs += __shfl_xor(cs, 32); bs += __shfl_xor(bs, 32);
        if (lane < 32) { const int d = dest_col(n0 + lane, perm); atomicAdd(cvec + d, cs); atomicAdd(bvec + d, bs); } }
    LDS_WAIT(); asm volatile("" ::: "memory");
    const int c = lane & 7;
#pragma unroll
    for (int j = 0; j < 4; ++j) { const int n = (lane >> 3) + 8 * j; const LAS float* s = scr + (8 * c) * 33 + n;
        v4u o; o.x = pk2(s[0 * 33], s[1 * 33]); o.y = pk2(s[2 * 33], s[3 * 33]); o.z = pk2(s[4 * 33], s[5 * 33]); o.w = pk2(s[6 * 33], s[7 * 33]);
        *(GAS v4u*)(WT + (size_t)dest_col(n0 + n, perm) * K + k0 + 8 * c) = o; }
    LDS_WAIT(); asm volatile("" ::: "memory");
}

struct Args { const float* in[16]; float* out; unsigned char* ws; int ph_lo, ph_hi; };

namespace lru {
constexpr int L_WA = 0, L_WX = 8192, L_XB = 16384, L_XC = L_XB + 33792, L_CMP = L_XC + 32768, L_GT = L_CMP + 2048, L_CW = L_GT + 8192, L_END = L_CW + 2560;
static_assert(L_END <= RING_BYTES, "lru lds");
__device__ __forceinline__ void phase(LAS unsigned char* lds, int vcu, const bf16* xb, const bf16* gate, bf16* hg, const bf16* wta, const bf16* wtx,
                                      const float* conv_w, const float* conv_b, const float* b_a, const float* b_x, const float* lam) {
    typedef float f32x4 __attribute__((ext_vector_type(4)));
    int tid_ = threadIdx.x; asm volatile("" : "+v"(tid_));
    const int tid = tid_, w = __builtin_amdgcn_readfirstlane(tid >> 6), lane = tid & 63, l15 = lane & 15, q = lane >> 4;
    const int b = vcu >> 5, g = (vcu >> 2) & 7, qd = vcu & 3, ch0 = g * 128 + qd * 32;
    { const int n = tid >> 4, ck = tid & 15;
      const v4u va = *(const GAS v4u*)(wta + ((size_t)(g * 128 + qd * 32 + n)) * 128 + ck * 8), vx = *(const GAS v4u*)(wtx + ((size_t)(g * 128 + qd * 32 + n)) * 128 + ck * 8);
      *(LAS v4u*)(lds + L_WA + n * 256 + ((ck ^ (n & 15)) * 16)) = va; *(LAS v4u*)(lds + L_WX + n * 256 + ((ck ^ (n & 15)) * 16)) = vx;
      if (tid < 128) { LAS float* cw = (LAS float*)(lds + L_CW);
#pragma unroll
          for (int tap = 0; tap < 4; ++tap) cw[tap * 128 + tid] = conv_w[tap * 1024 + g * 128 + tid];
          cw[4 * 128 + tid] = conv_b[g * 128 + tid]; } }
    float ba[2], bx[2], la2[2], carry[2];
#pragma unroll
    for (int nt = 0; nt < 2; ++nt) { const int ch = ch0 + nt * 16 + l15; ba[nt] = b_a[ch]; bx[nt] = b_x[ch];
        const float nl = -lam[ch]; const float sp = fmaxf(nl, 0.f) + log1pf(expf(-fabsf(nl)));
        la2[nt] = -8.0f * sp * 1.4426950408889634f; carry[nt] = 0.f; }
    __syncthreads();
    const size_t rowbase = (size_t)b * SEQ;
    for (int c = 0; c < SEQ / 128; ++c) {
        const int t0 = c * 128;
        for (int i = tid; i < 131 * 16; i += NWAVES * 64) { const int r = i >> 4, ck = i & 15, tok = t0 - 3 + r; v4u v = {0u, 0u, 0u, 0u};
            if (tok >= 0) v = *(const GAS v4u*)(xb + (rowbase + tok) * 1024 + g * 128 + ck * 8);
            *(LAS v4u*)(lds + L_XB + r * 256 + ck * 16) = v; }
        { const int r = tid >> 2, ck = tid & 3; *(LAS v4u*)(lds + L_GT + r * 64 + ck * 16) = *(const GAS v4u*)(gate + (rowbase + t0 + r) * 1024 + ch0 + ck * 8); }
        __syncthreads();
        { const int ck = tid & 15; const LAS float* cw = (const LAS float*)(lds + L_CW);
          float wt[4][8], cb[8];
#pragma unroll
          for (int j = 0; j < 8; ++j) { cb[j] = cw[4 * 128 + ck * 8 + j];
#pragma unroll
              for (int tap = 0; tap < 4; ++tap) wt[tap][j] = cw[tap * 128 + ck * 8 + j]; }
#pragma unroll
          for (int i = 0; i < 4; ++i) { const int tok = (tid >> 4) + 32 * i; float a[8];
#pragma unroll
              for (int j = 0; j < 8; ++j) a[j] = cb[j];
#pragma unroll
              for (int tap = 0; tap < 4; ++tap) { const v4u xv = *(const LAS v4u*)(lds + L_XB + (tok + tap) * 256 + ck * 16);
                  const unsigned xw[4] = {xv.x, xv.y, xv.z, xv.w};
#pragma unroll
                  for (int j = 0; j < 4; ++j) { a[2 * j] = fmaf(wt[tap][2 * j], __uint_as_float(xw[j] << 16), a[2 * j]); a[2 * j + 1] = fmaf(wt[tap][2 * j + 1], __uint_as_float(xw[j] & 0xffff0000u), a[2 * j + 1]); } }
              v4u o; o.x = pk2(a[0], a[1]); o.y = pk2(a[2], a[3]); o.z = pk2(a[4], a[5]); o.w = pk2(a[6], a[7]);
              *(LAS v4u*)(lds + L_XC + tok * 256 + ((ck ^ (tok & 15)) * 16)) = o; } }
        __syncthreads();
        f32x4 accR[2], accI[2];
#pragma unroll
        for (int nt = 0; nt < 2; ++nt) { accR[nt] = (f32x4){0.f, 0.f, 0.f, 0.f}; accI[nt] = (f32x4){0.f, 0.f, 0.f, 0.f}; }
#pragma unroll
        for (int s = 0; s < 4; ++s) { const int ck = 4 * s + q;
            const bf16x8 af = *(const LAS bf16x8*)(lds + L_XC + (16 * w + l15) * 256 + ((ck ^ l15) * 16));
#pragma unroll
            for (int nt = 0; nt < 2; ++nt) {
                const bf16x8 bfa = *(const LAS bf16x8*)(lds + L_WA + (nt * 16 + l15) * 256 + ((ck ^ l15) * 16));
                const bf16x8 bfx = *(const LAS bf16x8*)(lds + L_WX + (nt * 16 + l15) * 256 + ((ck ^ l15) * 16));
                accR[nt] = __builtin_amdgcn_mfma_f32_16x16x32_bf16(af, bfa, accR[nt], 0, 0, 0);
                accI[nt] = __builtin_amdgcn_mfma_f32_16x16x32_bf16(af, bfx, accI[nt], 0, 0, 0); } }
        float av[2][4], bv[2][4], Aex[2], Hex[2];
        LAS f32x2v* cmp = (LAS f32x2v*)(lds + L_CMP);
#pragma unroll
        for (int nt = 0; nt < 2; ++nt) { const int cl = qd * 32 + nt * 16 + l15; float A = 1.f, H = 0.f;
#pragma unroll
            for (int i = 0; i < 4; ++i) { const int tok = 16 * w + 4 * q + i;
                const float xcv = bf2f(*(const LAS unsigned short*)(lds + L_XC + tok * 256 + (((cl >> 3) ^ (tok & 15)) * 16) + (cl & 7) * 2));
                const float r = pg8::fast_sigmoid(accR[nt][i] + ba[nt]), ig = pg8::fast_sigmoid(accI[nt][i] + bx[nt]);
                const float a = __builtin_amdgcn_exp2f(la2[nt] * r); const float mult = __builtin_amdgcn_sqrtf(fmaxf(fmaf(-a, a, 1.0f), 0.f));
                av[nt][i] = a; bv[nt][i] = mult * (ig * xcv); H = fmaf(a, H, bv[nt][i]); A *= a; }
            { float Ap = __shfl_up(A, 16), Hp = __shfl_up(H, 16); if (q >= 1) { H = fmaf(A, Hp, H); A *= Ap; } }
            { float Ap = __shfl_up(A, 32), Hp = __shfl_up(H, 32); if (q >= 2) { H = fmaf(A, Hp, H); A *= Ap; } }
            { float Ap = __shfl_up(A, 16), Hp = __shfl_up(H, 16); Aex[nt] = q >= 1 ? Ap : 1.f; Hex[nt] = q >= 1 ? Hp : 0.f; }
            if (q == 3) cmp[w * 32 + nt * 16 + l15] = (f32x2v){A, H}; }
        __syncthreads();
#pragma unroll
        for (int nt = 0; nt < 2; ++nt) { float Ap = 1.f, Hp = 0.f, At = 1.f, Ht = 0.f;
#pragma unroll
            for (int v = 0; v < 8; ++v) { const f32x2v e = cmp[v * 32 + nt * 16 + l15]; Ht = fmaf(e.x, Ht, e.y); At *= e.x; if (v < w) { Hp = Ht; Ap = At; } }
            float h = fmaf(Ap, carry[nt], Hp);
            h = fmaf(Aex[nt], h, Hex[nt]);
#pragma unroll
            for (int i = 0; i < 4; ++i) { const int tok = 16 * w + 4 * q + i; h = fmaf(av[nt][i], h, bv[nt][i]);
                LAS unsigned short* gp = (LAS unsigned short*)(lds + L_GT + tok * 64 + (nt * 16 + l15) * 2);
                *gp = (unsigned short)f2bf(h * bf2f(*gp)); }
            carry[nt] = fmaf(At, carry[nt], Ht); }
        __syncthreads();
        { const int r = tid >> 2, ck = tid & 3; *(GAS v4u*)(hg + (rowbase + t0 + r) * 1024 + ch0 + ck * 8) = *(const LAS v4u*)(lds + L_GT + r * 64 + ck * 16); }
    }
    __syncthreads();
}
}

__device__ __forceinline__ unsigned long long ld_tbl(LAS unsigned char* lds, int k) {
    const unsigned long long v = *(volatile LAS unsigned long long*)(lds + LDSCTL_OFF + 8 * k);
    return ((unsigned long long)(unsigned)__builtin_amdgcn_readfirstlane((int)(unsigned)(v >> 32)) << 32) | (unsigned long long)(unsigned)__builtin_amdgcn_readfirstlane((int)(unsigned)v);
}
#define INP(k) ((const float*)ld_tbl(lds, (k)))
#define OUTP() ((float*)ld_tbl(lds, 16))
#define WSP() ((unsigned char*)ld_tbl(lds, 17))
constexpr int NPHASES = 22;
__global__ void __launch_bounds__(NWAVES * 64, 2) mega_fwd(Args args) {
    extern __shared__ __attribute__((aligned(16))) unsigned char lds_raw[];
    LAS unsigned char* lds = (LAS unsigned char*)lds_raw;
    for (int u = threadIdx.x; u < (LDS_BYTES - LDSCTL_OFF) / 4; u += NWAVES * 64) ((LAS unsigned*)(lds + LDSCTL_OFF))[u] = 0u;
    __syncthreads();
    if (threadIdx.x < 18) { const unsigned long long v = threadIdx.x < 16 ? (unsigned long long)args.in[threadIdx.x] : (threadIdx.x == 16 ? (unsigned long long)args.out : (unsigned long long)args.ws);
        *(LAS unsigned long long*)(lds + LDSCTL_OFF + 8 * threadIdx.x) = v; }
    __syncthreads();
    XcdBarrier bar = xcd_barrier_post((unsigned*)(WSP() + WS_CTL) + CW_BAR, (volatile LAS unsigned*)(lds + MISC_OFF) + 8);
    const int lo = args.ph_lo, hi = args.ph_hi;
    int ph = 0;
#define PH_BEGIN if (ph >= lo && ph < hi) { const int G = gridDim.x, bx = blockIdx.x, vcu = (G % 8 == 0) ? (bx % 8) * (G / 8) + bx / 8 : bx; (void)vcu; unsigned char* ws = WSP(); (void)ws;
#define PH_END   if (ph + 1 < hi) { if (ph == 0) { cooperative_groups::this_grid().sync(); } else { xcd_barrier(bar); } } } ++ph;

    PH_BEGIN
    {
        const int lane = threadIdx.x & 63, wave = __builtin_amdgcn_readfirstlane(threadIdx.x >> 6);
        LAS float* scr = (LAS float*)(lds + RING_OFF + wave * 16384);
        const int gw = vcu * NWAVES + wave, NGW = G * NWAVES;
        float* vec = (float*)(ws + WS_VEC); bf16* Wb = (bf16*)(ws + WS_W);
        const float* lng = INP(14); const float* lnb = INP(15);
        constexpr int I_QKV = (1024 / 64) * (3072 / 32), I_SQ = (1024 / 64) * (1024 / 32), I_LIN = (1024 / 64) * (2048 / 32), I_FIN = (1024 / 64) * (5632 / 32), I_FOUT = (2816 / 64) * (1024 / 32), I_GT = 2 * 4;
        constexpr int NITEMS = 2 * I_QKV + 2 * I_SQ + 2 * I_LIN + 2 * I_SQ + 4 * I_FIN + 4 * I_FOUT + 32 * I_GT;
        for (int it = gw; it < NITEMS; it += NGW) {
            int r = it;
            if (r < I_QKV) { p0_item(INP(1), 1024, 3072, Wb + W_QKV, nullptr, nullptr, nullptr, nullptr, 0, scr, r, lane); continue; } r -= I_QKV;
            if (r < I_QKV) { p0_item(INP(1) + 1024ull * 3072, 1024, 3072, Wb + W_QKV + 3072ull * 1024, lng + 3 * 1024, lnb + 3 * 1024, vec + V_QKV + 3072, vec + V_TOTAL + V_QKV + 3072, 0, scr, r, lane); continue; } r -= I_QKV;
            if (r < 2 * I_SQ) { const int j = r / I_SQ; p0_item(INP(2) + (size_t)j * 1024 * 1024, 1024, 1024, Wb + W_WO + (size_t)j * 1024 * 1024, nullptr, nullptr, nullptr, nullptr, 0, scr, r % I_SQ, lane); continue; } r -= 2 * I_SQ;
            if (r < 2 * I_LIN) { const int j = r / I_LIN, li = (j == 0) ? 1 : 5;
                p0_item(INP(3) + (size_t)j * 1024 * 2048, 1024, 2048, Wb + W_LIN + (size_t)j * 2048 * 1024, lng + li * 1024, lnb + li * 1024, vec + V_LIN + j * 2048, vec + V_TOTAL + V_LIN + j * 2048, 0, scr, r % I_LIN, lane); continue; } r -= 2 * I_LIN;
            if (r < 2 * I_SQ) { const int j = r / I_SQ; p0_item(INP(11) + (size_t)j * 1024 * 1024, 1024, 1024, Wb + W_LOUT + (size_t)j * 1024 * 1024, nullptr, nullptr, nullptr, nullptr, 0, scr, r % I_SQ, lane); continue; } r -= 2 * I_SQ;
            if (r < 4 * I_FIN) { const int i = r / I_FIN, li = 2 * i;
                p0_item(INP(12) + (size_t)i * 1024 * 5632, 1024, 5632, Wb + W_FIN + (size_t)i * 5632 * 1024, lng + li * 1024, lnb + li * 1024, vec + V_FIN + i * 5632, vec + V_TOTAL + V_FIN + i * 5632, 1, scr, r % I_FIN, lane); continue; } r -= 4 * I_FIN;
            if (r < 4 * I_FOUT) { const int i = r / I_FOUT; p0_item(INP(13) + (size_t)i * 2816 * 1024, 2816, 1024, Wb + W_FOUT + (size_t)i * 1024 * 2816, nullptr, nullptr, nullptr, nullptr, 0, scr, r % I_FOUT, lane); continue; } r -= 4 * I_FOUT;
            { const int mat = r / I_GT, which = mat >> 4, jg = mat & 15;
              p0_item(INP(which ? 8 : 6) + (size_t)jg * 16384, 128, 128, Wb + (which ? W_GX : W_GA) + (size_t)jg * 16384, nullptr, nullptr, nullptr, nullptr, 0, scr, r % I_GT, lane); }
        }
        const float* x = INP(0); bf16* XB16 = (bf16*)(ws + WS_XB16);
        for (int m = gw; m < M; m += NGW) {
            const GAS f32x4* xr = (const GAS f32x4*)(x + (size_t)m * DM) + lane; GAS unsigned long long* o8 = (GAS unsigned long long*)(XB16 + (size_t)m * DM) + lane;
#pragma unroll
            for (int j = 0; j < 4; ++j) { const f32x4 v = xr[64 * j]; o8[64 * j] = (unsigned long long)pk2(v.x, v.y) | ((unsigned long long)pk2(v.z, v.w) << 32); }
        }
    }
    PH_END

#pragma nounroll
    for (int layer_ = 0; layer_ < DEPTH; ++layer_) {
#define LAYER_VARS int layer = layer_; asm volatile("" : "+s"(layer)); const int j = layer >> 1; (void)j; \
        float* stats = (float*)(ws + WS_STATS); bf16* Wb = (bf16*)(ws + WS_W); bf16* XB16 = (bf16*)(ws + WS_XB16); unsigned char* T = ws + WS_T; (void)Wb; (void)XB16; (void)T; \
        const float* st_mix_in = layer ? stats + (size_t)(2 * layer - 1) * M * 2 : nullptr; float* st_mix_out = stats + (size_t)(2 * layer) * M * 2; float* st_ffn_out = stats + (size_t)(2 * layer + 1) * M * 2; \
        (void)st_mix_in; (void)st_mix_out; (void)st_ffn_out;
        if ((layer_ & 1) == 0) {
            PH_BEGIN
            {
                LAYER_VARS
                float* vec = (float*)(ws + WS_VEC); float* ks_l = (float*)(ws + WS_KSUM) + (size_t)j * 64 * 1024;
                pg8::Gemm g{XB16, Wb + W_QKV + (size_t)j * 3072 * 1024, M, 3072, 1024}; pg8::StaticOrder S; S.init(M, 3072, G, bx);
                pg8::EpiIn<0> E{st_mix_in, vec + V_QKV + j * 3072, vec + V_TOTAL + V_QKV + j * 3072, (bf16*)T, ks_l};
#ifndef NO_G0
                pg8::gemm_phase<pg8::EpiIn<0>, pg8::StaticOrder, true, true>(lds + RING_OFF, g, S, E);
#endif
            }
            PH_END
            PH_BEGIN
            {
                LAYER_VARS
#ifndef NO_ATTN
                if (vcu < 256) {
                    bf16* Qb = (bf16*)T; bf16* Kb = (bf16*)(T + 32 * MiB); bf16* Vb = (bf16*)(T + 64 * MiB); bf16* Ob = (bf16*)(T + 96 * MiB);
                    const float* ks_l = (const float*)(ws + WS_KSUM) + (size_t)j * 64 * 1024;
                    const int bh = vcu >> 2, xq = vcu & 3, b = bh >> 3, h = bh & 7;
                    const float ksl = exp2f(-(float)(h + 1)) / moba::SCALE;
                    const size_t hb = (size_t)b * SEQ * 1024 + (size_t)h * 128;
                    moba::BlockRef cur{Qb + hb + (size_t)xq * 256 * 1024, Kb + hb, Vb + hb, Ob + hb + (size_t)xq * 256 * 1024, ks_l + (size_t)b * 8 * 1024 + h * 128, xq, ksl};
                    moba::Seam S;
                    moba::moba_prime(cur, (char*)lds_raw + RING_OFF, S);
#pragma nounroll
                    for (int pass = 0; pass < 2; ++pass) {
                        moba::BlockRef nxt = cur; nxt.qb = 7 - xq; nxt.Q = Qb + hb + (size_t)(7 - xq) * 256 * 1024; nxt.O = Ob + hb + (size_t)(7 - xq) * 256 * 1024;
                        moba::moba_block(cur, nxt, (char*)lds_raw + RING_OFF, S); cur = nxt; }
                }
#endif
            }
            PH_END
            PH_BEGIN
            {
                LAYER_VARS
                const float* lng = INP(14); const float* lnb = INP(15);
                pg8::Gemm g{(bf16*)(T + 96 * MiB), Wb + W_WO + (size_t)j * 1024 * 1024, M, 1024, 1024}; pg8::StaticOrder S; S.init(M, 1024, G, bx);
                pg8::EpiOut E{INP(0), st_mix_in, layer ? lng + (size_t)(2 * layer - 1) * 1024 : nullptr, layer ? lnb + (size_t)(2 * layer - 1) * 1024 : nullptr, OUTP(), XB16, st_mix_out};
#ifndef NO_GOUT
                pg8::gemm_phase<pg8::EpiOut, pg8::StaticOrder, true, true>(lds + RING_OFF, g, S, E);
#endif
            }
            PH_END
        } else {
            PH_BEGIN
            {
                LAYER_VARS
                float* vec = (float*)(ws + WS_VEC);
                pg8::Gemm g{XB16, Wb + W_LIN + (size_t)j * 2048 * 1024, M, 2048, 1024}; pg8::StaticOrder S; S.init(M, 2048, G, bx);
                pg8::EpiIn<1> E{st_mix_in, vec + V_LIN + j * 2048, vec + V_TOTAL + V_LIN + j * 2048, (bf16*)T, nullptr};
#ifndef NO_G1
                pg8::gemm_phase<pg8::EpiIn<1>, pg8::StaticOrder, true, true>(lds + RING_OFF, g, S, E);
#endif
            }
            PH_END
            PH_BEGIN
            {
                LAYER_VARS
#ifndef NO_LRU
                if (vcu < 256)
                    lru::phase(lds + RING_OFF, vcu, (bf16*)T, (bf16*)(T + 32 * MiB), (bf16*)(T + 64 * MiB), Wb + W_GA + (size_t)j * 8 * 16384, Wb + W_GX + (size_t)j * 8 * 16384,
                               INP(4) + (size_t)j * 4 * 1024, INP(5) + (size_t)j * 1024, INP(7) + (size_t)j * 1024, INP(9) + (size_t)j * 1024, INP(10) + (size_t)j * 1024);
#endif
            }
            PH_END
            PH_BEGIN
            {
                LAYER_VARS
                const float* lng = INP(14); const float* lnb = INP(15);
                pg8::Gemm g{(bf16*)(T + 64 * MiB), Wb + W_LOUT + (size_t)j * 1024 * 1024, M, 1024, 1024}; pg8::StaticOrder S; S.init(M, 1024, G, bx);
                pg8::EpiOut E{INP(0), st_mix_in, lng + (size_t)(2 * layer - 1) * 1024, lnb + (size_t)(2 * layer - 1) * 1024, OUTP(), XB16, st_mix_out};
#ifndef NO_GOUT
                pg8::gemm_phase<pg8::EpiOut, pg8::StaticOrder, true, true>(lds + RING_OFF, g, S, E);
#endif
            }
            PH_END
        }
        PH_BEGIN
        {
            LAYER_VARS
            float* vec = (float*)(ws + WS_VEC);
            pg8::Gemm g{XB16, Wb + W_FIN + (size_t)layer * 5632 * 1024, M, 5632, 1024}; pg8::StaticOrder S; S.init(M, 5632, G, bx);
            pg8::EpiIn<2> E{st_mix_out, vec + V_FIN + layer * 5632, vec + V_TOTAL + V_FIN + layer * 5632, (bf16*)T, nullptr};
#ifndef NO_G2
            pg8::gemm_phase<pg8::EpiIn<2>, pg8::StaticOrder, true, true>(lds + RING_OFF, g, S, E);
#endif
        }
        PH_END
        PH_BEGIN
        {
            LAYER_VARS
            const float* lng = INP(14); const float* lnb = INP(15);
            pg8::Gemm g{(bf16*)T, Wb + W_FOUT + (size_t)layer * 1024 * 2816, M, 1024, 2816}; pg8::StaticOrder S; S.init(M, 1024, G, bx);
            pg8::EpiOut E{INP(0), st_mix_out, lng + (size_t)(2 * layer) * 1024, lnb + (size_t)(2 * layer) * 1024, OUTP(), XB16, st_ffn_out};
#ifndef NO_GOUT
            pg8::gemm_phase<pg8::EpiOut, pg8::StaticOrder, true, true>(lds + RING_OFF, g, S, E);
#endif
        }
        PH_END
    }
    PH_BEGIN
    {
        const int lane = threadIdx.x & 63, wave = __builtin_amdgcn_readfirstlane(threadIdx.x >> 6);
        const int gw = vcu * NWAVES + wave, NGW = G * NWAVES;
        const float* lg = INP(14) + 7 * 1024; const float* lb = INP(15) + 7 * 1024; float* pre = OUTP();
        f32x4 gv[4], bv[4];
#pragma unroll
        for (int jj = 0; jj < 4; ++jj) { gv[jj] = *((const GAS f32x4*)lg + lane + 64 * jj); bv[jj] = *((const GAS f32x4*)lb + lane + 64 * jj); }
        for (int m = gw; m < M; m += NGW) {
            GAS f32x4* xr = (GAS f32x4*)(pre + (size_t)m * DM) + lane;
            f32x4 v[4]; float s = 0.f;
#pragma unroll
            for (int jj = 0; jj < 4; ++jj) { v[jj] = xr[64 * jj]; s += (v[jj].x + v[jj].y) + (v[jj].z + v[jj].w); }
            const float mean = wave_sum(s) * (1.f / DM); float s2 = 0.f;
#pragma unroll
            for (int jj = 0; jj < 4; ++jj) { v[jj] = v[jj] - mean; s2 += (v[jj].x * v[jj].x + v[jj].y * v[jj].y) + (v[jj].z * v[jj].z + v[jj].w * v[jj].w); }
            const float rstd = 1.f / sqrtf(wave_sum(s2) * (1.f / DM) + 1e-5f);
#pragma unroll
            for (int jj = 0; jj < 4; ++jj) xr[64 * jj] = v[jj] * rstd * gv[jj] + bv[jj];
        }
    }
    PH_END
#undef PH_BEGIN
#undef PH_END
#undef LAYER_VARS
}

extern "C" void kernel_launch(void* const* d_in, const int* in_sizes, int n_in, void* d_out, int out_size, void* d_ws, size_t ws_size, hipStream_t stream) {
    static int grid = 0;
    if (grid == 0) {
        if (n_in != 16 || in_sizes[0] != M * DM || out_size != M * DM || ws_size < WS_END) { fprintf(stderr, "kernel_launch: shape/workspace mismatch (n_in %d, in0 %d, out %d, ws %zu)\n", n_in, n_in > 0 ? in_sizes[0] : -1, out_size, ws_size); grid = -1; return; }
        int dev = 0, cus = 0, per_cu = 0;
        if (hipGetDevice(&dev) != hipSuccess || hipDeviceGetAttribute(&cus, hipDeviceAttributeMultiprocessorCount, dev) != hipSuccess) { fprintf(stderr, "kernel_launch: device query failed\n"); grid = -1; return; }
        if (hipFuncSetAttribute((const void*)mega_fwd, hipFuncAttributeMaxDynamicSharedMemorySize, LDS_BYTES) != hipSuccess) { fprintf(stderr, "kernel_launch: hipFuncSetAttribute failed\n"); grid = -1; return; }
        if (hipOccupancyMaxActiveBlocksPerMultiprocessor(&per_cu, (const void*)mega_fwd, NWAVES * 64, LDS_BYTES) != hipSuccess || per_cu < 1) { fprintf(stderr, "kernel_launch: occupancy query says %d blocks per CU\n", per_cu); grid = -1; (void)hipGetLastError(); return; }
        grid = cus;
        if (grid != 256) fprintf(stderr, "kernel_launch: %d CUs; this kernel is laid out for 256\n", grid);
    }
    if (grid < 0) return;
    if (hipMemsetAsync((char*)d_ws + WS_CTL, 0, ZERO_BYTES, stream) != hipSuccess) { fprintf(stderr, "kernel_launch: memset failed\n"); return; }
    Args a{};
    for (int i = 0; i < 16; ++i) a.in[i] = (const float*)d_in[i];
    a.out = (float*)d_out; a.ws = (unsigned char*)d_ws; a.ph_lo = 0; a.ph_hi = NPHASES;
    void* kargs[] = {&a};
    hipError_t e = hipLaunchCooperativeKernel((const void*)mega_fwd, dim3(grid), dim3(NWAVES * 64), kargs, LDS_BYTES, stream);
    if (e != hipSuccess) fprintf(stderr, "kernel_launch: cooperative launch failed: %s (grid %d)\n", hipGetErrorString(e), grid);
}
```

```cpp
#include <hip/hip_runtime.h>
#include <hip/hip_cooperative_groups.h>
#include <cstdio>
#include <cstdint>
namespace pg8 {
#define PG8_LAS __attribute__((address_space(3)))
typedef unsigned short bf16_t;
typedef short bf16x8 __attribute__((ext_vector_type(8)));
typedef float f32x4 __attribute__((ext_vector_type(4)));
typedef unsigned u32x4 __attribute__((ext_vector_type(4)));
constexpr int BM = 256, BK = 64, HALF = 128, HTB = HALF * BK * 2  , STAGE_BYTES = 8 * HTB, NXCD = 8, WGM = 8;

__host__ __device__ __forceinline__ int lds_byte(int r, int c) { const int st = (r >> 4) * 2 + (c >> 5), rr = r & 15, cc = c & 31, ob = rr * 64 + cc * 2; return st * 1024 + (ob ^ (((ob >> 9) & 1) << 5)); }
__host__ __device__ __forceinline__ void stage_rc(int b, int& R, int& C) { const int st = b / 1024, sb = b % 1024, swz = sb ^ (((sb >> 9) & 1) << 5); R = (st >> 1) * 16 + swz / 64; C = (st & 1) * 32 + (swz % 64) / 2; }
__host__ __device__ __forceinline__ int perm32(int rho) { const int n = rho >> 4, i = rho & 15; return 8 * (i >> 2) + 4 * n + (i & 3); }

struct Unit { int pm, pn; };
struct Gemm { const bf16_t* A; const bf16_t* Bt; int M, N, K; };

struct StaticOrder {
    int nM, nN, nwg, G, c;
    __host__ __device__ void init(int M, int N, int G_, int c_) { nM = M / BM; nN = N / BM; nwg = nM * nN; G = G_; c = c_; }
    __host__ __device__ bool next(int i, Unit& u) const {
        const long L = (long)i * G + c; if (L >= nwg) return false;
        int wgid = (int)L; { const int q = nwg / NXCD, r = nwg % NXCD, xcd = wgid % NXCD, off = wgid / NXCD; wgid = (xcd < r ? xcd * (q + 1) : r * (q + 1) + (xcd - r) * q) + off; }
        const int nig = WGM * nN, gid = wgid / nig, fm = gid * WGM, gsz = (nM - fm) < WGM ? (nM - fm) : WGM;
        u.pm = fm + ((wgid % nig) % gsz); u.pn = (wgid % nig) / gsz; return true;
    }
    __device__ __forceinline__ void a_ready(const Unit&) const {}
    __device__ __forceinline__ void done(const Unit&) const {}
};
__device__ __forceinline__ unsigned cvt_pk_bf16(float lo, float hi) { unsigned r; asm volatile("v_cvt_pk_bf16_f32 %0, %1, %2" : "=v"(r) : "v"(lo), "v"(hi)); return r; }
typedef float f32x2 __attribute__((ext_vector_type(2)));
typedef unsigned u32x2 __attribute__((ext_vector_type(2)));
#ifndef RES16
#define RES16 0
#endif
constexpr float LN_EPS = 1e-5f, DN_ALPHA = 1.6817928305074290f, LOG2E = 1.4426950408889634f;
__device__ __forceinline__ float fast_sigmoid(float x) { return __builtin_amdgcn_rcpf(1.0f + __builtin_amdgcn_exp2f(-x * LOG2E)); }
__device__ __forceinline__ float gelu_tanh(float y) { const float u = 0.7978845608028654f * (y + 0.044715f * y * y * y); return y * fast_sigmoid(2.0f * u); }
__device__ __forceinline__ void row_mu_rs(const float* st, int row, float& mu, float& rs) {
    if (st == nullptr) { mu = 0.f; rs = 1.f; return; }
    const f32x4 a = *(const f32x4*)(st + 8 * (size_t)row), b = *(const f32x4*)(st + 8 * (size_t)row + 4);
    const float sm = (a[0] + a[2]) + (b[0] + b[2]), sq = (a[1] + a[3]) + (b[1] + b[3]);
    mu = sm * (1.0f / 1024.0f); const float var = fmaxf(sq * (1.0f / 1024.0f) - mu * mu, 0.f); rs = __builtin_amdgcn_rsqf(var + LN_EPS);
}

template <int MODE> struct EpiIn {
    static constexpr bool PERM = true, AFTER_DRAIN = false;
    const float* st; const float* cvec; const float* bvec; bf16_t* o0; float* ksum; int dry;
    __device__ __forceinline__ void operator()(const f32x4 (&acc)[2][2][4][2], const Unit& u, int wr, int wc, int fr, int fq) const {
        const int row0 = u.pm * BM + wr * 64 + fr, cl = wc * 32 + 8 * fq, colt = u.pn * BM;
        if (MODE == 2) {
            f32x4 cg[2], cu[2], bg[2], bu[2];
#pragma unroll
            for (int n = 0; n < 2; ++n) { cg[n] = *(const f32x4*)(cvec + colt + cl + 4 * n); cu[n] = *(const f32x4*)(cvec + colt + HALF + cl + 4 * n);
                bg[n] = *(const f32x4*)(bvec + colt + cl + 4 * n); bu[n] = *(const f32x4*)(bvec + colt + HALF + cl + 4 * n); }
#pragma unroll
            for (int ai = 0; ai < 2; ++ai)
#pragma unroll
                for (int m = 0; m < 4; ++m) {
                    float mu, rs; row_mu_rs(st, row0 + ai * HALF + m * 16, mu, rs);
                    unsigned wv[4];
#pragma unroll
                    for (int n = 0; n < 2; ++n) {
                        const f32x4 g = (acc[ai][0][m][n] - mu * cg[n]) * rs + bg[n], uu = (acc[ai][1][m][n] - mu * cu[n]) * rs + bu[n];
                        float a[4];
#pragma unroll
                        for (int j = 0; j < 4; ++j) a[j] = g[j] * fast_sigmoid(g[j]) * uu[j];
                        wv[2 * n] = cvt_pk_bf16(a[0], a[1]); wv[2 * n + 1] = cvt_pk_bf16(a[2], a[3]);
                    }
                    const u32x4 w = {wv[0], wv[1], wv[2], wv[3]};
                    if (!dry) *(u32x4*)(o0 + (size_t)(row0 + ai * HALF + m * 16) * 2816 + u.pn * HALF + cl) = w; else asm volatile("" :: "v"(w.x), "v"(w.y), "v"(w.z), "v"(w.w));
                }
        } else {
            bf16_t* base; const int ocol = (u.pn & 3) * BM;
            base = o0 + (size_t)(u.pn >> 2) * ((size_t)16384 * 1024);
            const bool is_k = (MODE == 0) && ((u.pn >> 2) == 1), is_gate = (MODE == 1) && (u.pn >= 4);
#pragma unroll
            for (int bj = 0; bj < 2; ++bj) {
                const f32x4 c0 = *(const f32x4*)(cvec + colt + bj * HALF + cl), c1 = *(const f32x4*)(cvec + colt + bj * HALF + cl + 4);
                const f32x4 b0 = *(const f32x4*)(bvec + colt + bj * HALF + cl), b1 = *(const f32x4*)(bvec + colt + bj * HALF + cl + 4);
                f32x4 s0 = {0.f, 0.f, 0.f, 0.f}, s1 = {0.f, 0.f, 0.f, 0.f};
#pragma unroll
                for (int ai = 0; ai < 2; ++ai)
#pragma unroll
                    for (int m = 0; m < 4; ++m) {
                        float mu, rs; row_mu_rs(st, row0 + ai * HALF + m * 16, mu, rs);
                        f32x4 v0 = (acc[ai][bj][m][0] - mu * c0) * rs + b0, v1 = (acc[ai][bj][m][1] - mu * c1) * rs + b1;
                        if (MODE == 0) { s0 += v0; s1 += v1; }
                        if (MODE == 1 && is_gate) {
#pragma unroll
                            for (int j = 0; j < 4; ++j) { v0[j] = gelu_tanh(v0[j]); v1[j] = gelu_tanh(v1[j]); }
                        }
                        u32x4 w; w.x = cvt_pk_bf16(v0[0], v0[1]); w.y = cvt_pk_bf16(v0[2], v0[3]); w.z = cvt_pk_bf16(v1[0], v1[1]); w.w = cvt_pk_bf16(v1[2], v1[3]);
                        if (!dry) *(u32x4*)(base + (size_t)(row0 + ai * HALF + m * 16) * 1024 + ocol + bj * HALF + cl) = w; else asm volatile("" :: "v"(w.x), "v"(w.y), "v"(w.z), "v"(w.w));
                    }
                if (MODE == 0 && is_k) {
                    float t0 = s0[0], t1 = s0[1], t2 = s0[2], t3 = s0[3], t4 = s1[0], t5 = s1[1], t6 = s1[2], t7 = s1[3];
#define RED16(v) v += __shfl_xor(v, 1); v += __shfl_xor(v, 2); v += __shfl_xor(v, 4); v += __shfl_xor(v, 8)
                    RED16(t0); RED16(t1); RED16(t2); RED16(t3); RED16(t4); RED16(t5); RED16(t6); RED16(t7);
#undef RED16
                    if (fr == 0 && !dry) { float* kp = ksum + (size_t)u.pm * 1024 + ocol + bj * HALF + cl;
                        atomicAdd(kp + 0, t0); atomicAdd(kp + 1, t1); atomicAdd(kp + 2, t2); atomicAdd(kp + 3, t3);
                        atomicAdd(kp + 4, t4); atomicAdd(kp + 5, t5); atomicAdd(kp + 6, t6); atomicAdd(kp + 7, t7); }
                }
            }
        }
    }
};

struct EpiOut {
    static constexpr bool PERM = true, AFTER_DRAIN = false;
    const float* xin; const float* st_in; const float* lg; const float* lb; float* pre; bf16_t* pre16; float* st_out; int dry; PG8_LAS float* sp;
    __device__ __forceinline__ void operator()(const f32x4 (&acc)[2][2][4][2], const Unit& u, int wr, int wc, int fr, int fq) const {
        const int row0 = u.pm * BM + wr * 64 + fr, col0 = u.pn * BM + wc * 32 + 8 * fq;
        const bool ln = st_in != nullptr;
#if RES16
        u32x4 na, nb; f32x4 nsa = {0.f, 0.f, 0.f, 0.f}, nsb = nsa;
        { const size_t off = (size_t)row0 * 1024 + col0; na = *(const u32x4*)(pre16 + off); nb = *(const u32x4*)(pre16 + off + HALF);
          if (ln) { nsa = *(const f32x4*)(st_in + 8 * (size_t)row0); nsb = *(const f32x4*)(st_in + 8 * (size_t)row0 + 4); } }
#else
        const float* src = ln ? pre : xin;
        f32x4 nx[4]; f32x4 nsa = {0.f, 0.f, 0.f, 0.f}, nsb = nsa;
        { const size_t off = (size_t)row0 * 1024 + col0;
          nx[0] = *(const f32x4*)(src + off); nx[1] = *(const f32x4*)(src + off + 4); nx[2] = *(const f32x4*)(src + off + HALF); nx[3] = *(const f32x4*)(src + off + HALF + 4);
          if (ln) { nsa = *(const f32x4*)(st_in + 8 * (size_t)row0); nsb = *(const f32x4*)(st_in + 8 * (size_t)row0 + 4); } }
#endif
#pragma unroll
        for (int i = 0; i < 8; ++i) {
            const int ai = i >> 2, m = i & 3, row = row0 + ai * HALF + m * 16;
            f32x4 cx[4]; const float csm = (nsa[0] + nsa[2]) + (nsb[0] + nsb[2]), csq = (nsa[1] + nsa[3]) + (nsb[1] + nsb[3]);
#if RES16
            cx[0] = (f32x4){__uint_as_float(na.x << 16), __uint_as_float(na.x & 0xffff0000u), __uint_as_float(na.y << 16), __uint_as_float(na.y & 0xffff0000u)};
            cx[1] = (f32x4){__uint_as_float(na.z << 16), __uint_as_float(na.z & 0xffff0000u), __uint_as_float(na.w << 16), __uint_as_float(na.w & 0xffff0000u)};
            cx[2] = (f32x4){__uint_as_float(nb.x << 16), __uint_as_float(nb.x & 0xffff0000u), __uint_as_float(nb.y << 16), __uint_as_float(nb.y & 0xffff0000u)};
            cx[3] = (f32x4){__uint_as_float(nb.z << 16), __uint_as_float(nb.z & 0xffff0000u), __uint_as_float(nb.w << 16), __uint_as_float(nb.w & 0xffff0000u)};
            if (i + 1 < 8) { const int rown = row0 + ((i + 1) >> 2) * HALF + ((i + 1) & 3) * 16; const size_t offn = (size_t)rown * 1024 + col0;
                na = *(const u32x4*)(pre16 + offn); nb = *(const u32x4*)(pre16 + offn + HALF);
                if (ln) { nsa = *(const f32x4*)(st_in + 8 * (size_t)rown); nsb = *(const f32x4*)(st_in + 8 * (size_t)rown + 4); } }
#else
#pragma unroll
            for (int k = 0; k < 4; ++k) cx[k] = nx[k];
            if (i + 1 < 8) { const int rown = row0 + ((i + 1) >> 2) * HALF + ((i + 1) & 3) * 16; const size_t offn = (size_t)rown * 1024 + col0;
                nx[0] = *(const f32x4*)(src + offn); nx[1] = *(const f32x4*)(src + offn + 4); nx[2] = *(const f32x4*)(src + offn + HALF); nx[3] = *(const f32x4*)(src + offn + HALF + 4);
                if (ln) { nsa = *(const f32x4*)(st_in + 8 * (size_t)rown); nsb = *(const f32x4*)(st_in + 8 * (size_t)rown + 4); } }
#endif
            float mu = 0.f, rs = 1.f;
            if (ln) { mu = csm * (1.0f / 1024.0f); const float var = fmaxf(csq * (1.0f / 1024.0f) - mu * mu, 0.f); rs = __builtin_amdgcn_rsqf(var + LN_EPS); }
            float s = 0.f, q = 0.f;
#pragma unroll
            for (int bj = 0; bj < 2; ++bj) {
                f32x4 g0 = {1.f, 1.f, 1.f, 1.f}, g1 = g0, b0 = {0.f, 0.f, 0.f, 0.f}, b1 = b0;
                if (ln) { g0 = *(const f32x4*)(lg + col0 + bj * HALF); g1 = *(const f32x4*)(lg + col0 + bj * HALF + 4); b0 = *(const f32x4*)(lb + col0 + bj * HALF); b1 = *(const f32x4*)(lb + col0 + bj * HALF + 4); }
                const size_t off = (size_t)row * 1024 + col0 + bj * HALF;
                const f32x4 v0 = ((cx[2 * bj] - mu) * rs * g0 + b0) * DN_ALPHA + acc[ai][bj][m][0], v1 = ((cx[2 * bj + 1] - mu) * rs * g1 + b1) * DN_ALPHA + acc[ai][bj][m][1];
#if !RES16
                if (!dry) { *(f32x4*)(pre + off) = v0; *(f32x4*)(pre + off + 4) = v1; }
#endif
                u32x4 w; w.x = cvt_pk_bf16(v0[0], v0[1]); w.y = cvt_pk_bf16(v0[2], v0[3]); w.z = cvt_pk_bf16(v1[0], v1[1]); w.w = cvt_pk_bf16(v1[2], v1[3]);
                if (!dry) *(u32x4*)(pre16 + off) = w; else asm volatile("" :: "v"(w.x), "v"(w.y), "v"(w.z), "v"(w.w));
                s += ((v0[0] + v0[1]) + (v0[2] + v0[3])) + ((v1[0] + v1[1]) + (v1[2] + v1[3]));
                q += ((v0[0] * v0[0] + v0[1] * v0[1]) + (v0[2] * v0[2] + v0[3] * v0[3])) + ((v1[0] * v1[0] + v1[1] * v1[1]) + (v1[2] * v1[2] + v1[3] * v1[3]));
            }
            s += __shfl_xor(s, 16); s += __shfl_xor(s, 32); q += __shfl_xor(q, 16); q += __shfl_xor(q, 32);
            if (fq == 0) *(PG8_LAS f32x2*)(sp + ((ai * HALF + wr * 64 + m * 16 + fr) * 4 + wc) * 2) = (f32x2){s, q};
        }
        asm volatile("s_waitcnt lgkmcnt(0)" ::: "memory"); __builtin_amdgcn_s_barrier(); asm volatile("" ::: "memory");
        { const int t = wr * 256 + wc * 64 + fq * 16 + fr;
          if (t < 256 && !dry) { const f32x4 a = *(const PG8_LAS f32x4*)(sp + t * 8), b = *(const PG8_LAS f32x4*)(sp + t * 8 + 4);
              *(f32x2*)(st_out + 8 * (size_t)(u.pm * BM + t) + 2 * u.pn) = (f32x2){(a[0] + a[2]) + (b[0] + b[2]), (a[1] + a[3]) + (b[1] + b[3])}; } }
        asm volatile("s_waitcnt lgkmcnt(0)" ::: "memory"); __builtin_amdgcn_s_barrier(); asm volatile("" ::: "memory");
    }
};
template <class Epi, class Sched, bool ALIGN_EPI = false, bool SP2 = false>
__device__ __forceinline__ void gemm_phase(PG8_LAS unsigned char* lds, const Gemm g, const Sched& S, const Epi& E) {
    int tid_ = threadIdx.x; asm volatile("" : "+v"(tid_));
    const int tid = tid_, wid = __builtin_amdgcn_readfirstlane(tid >> 6), lane = tid & 63, wr = wid >> 2, wc = wid & 3, fr = lane & 15, fq = lane >> 4;
    const int K = g.K, nt = K / BK;
    unsigned voffA[2], voffB[2];
#pragma unroll
    for (int i = 0; i < 2; ++i) { int R, C; stage_rc(tid * 16 + i * 8192, R, C); const int Rb = Epi::PERM ? ((R & ~31) + perm32(R & 31)) : R;
        voffA[i] = (unsigned)(R * K + C) * 2u; voffB[i] = (unsigned)(Rb * K + C) * 2u; }
    const size_t kstep = (size_t)(BK * 2);
    const size_t hstep = (size_t)HALF * K * 2;
    const size_t tstep = 2 * hstep;
    const unsigned ldsw = (unsigned)wid * 1024u;
    const int aoff = lds_byte(wr * 64 + fr, fq * 8), boff = lds_byte(wc * 32 + fr, fq * 8);
#define PG8_SA(b, h) (((b) * 2 + (h)) * HTB)
#define PG8_SB(b, h) ((4 + (b) * 2 + (h)) * HTB)
#define PG8_STAGE(bufoff, gbase, voff) do { _Pragma("unroll") for (int _i = 0; _i < 2; ++_i) \
        __builtin_amdgcn_global_load_lds((const unsigned*)((const char*)(gbase) + (voff)[_i]), (PG8_LAS unsigned*)(lds + (bufoff) + ldsw + _i * 8192), 16, 0, 0); } while (0)
#define PG8_LDA(dst, b, h) do { _Pragma("unroll") for (int m = 0; m < 4; ++m) _Pragma("unroll") for (int k = 0; k < 2; ++k) dst[m][k] = *(const PG8_LAS bf16x8*)(lds + PG8_SA(b, h) + aoff + m * 2048 + k * 1024); } while (0)
#define PG8_LDB(dst, b, h) do { _Pragma("unroll") for (int n = 0; n < 2; ++n) _Pragma("unroll") for (int k = 0; k < 2; ++k) dst[n][k] = *(const PG8_LAS bf16x8*)(lds + PG8_SB(b, h) + boff + n * 2048 + k * 1024); } while (0)
#define PG8_MMA(ai, bj, At, Bt) do { __builtin_amdgcn_s_setprio(1); _Pragma("unroll") for (int m = 0; m < 4; ++m) _Pragma("unroll") for (int n = 0; n < 2; ++n) _Pragma("unroll") for (int k = 0; k < 2; ++k) \
        acc[ai][bj][m][n] = __builtin_amdgcn_mfma_f32_16x16x32_bf16(Bt[n][k], At[m][k], acc[ai][bj][m][n], 0, 0, 0); __builtin_amdgcn_s_setprio(0); } while (0)
#define PG8_WAIT_V(n) asm volatile("s_waitcnt vmcnt(" #n ")" ::: "memory")
#define PG8_WAIT_L(n) asm volatile("s_waitcnt lgkmcnt(" #n ")" ::: "memory")
#define PG8_BAR __builtin_amdgcn_s_barrier()
#define PG8_SCHED __builtin_amdgcn_sched_barrier(0)
    Unit cur, nxt; int ui = 0;
    if (!S.next(0, cur)) return;
    f32x4 acc[2][2][4][2];
#pragma unroll
    for (int a = 0; a < 2; ++a)
#pragma unroll
        for (int b = 0; b < 2; ++b)
#pragma unroll
            for (int m = 0; m < 4; ++m)
#pragma unroll
                for (int n = 0; n < 2; ++n) acc[a][b][m][n] = (f32x4){0.f, 0.f, 0.f, 0.f};
    bf16x8 At[4][2], B0[2][2], B1[2][2];
    const char* cA = (const char*)g.A + (size_t)cur.pm * tstep; const char* cB = (const char*)g.Bt + (size_t)cur.pn * tstep;
    S.a_ready(cur);
    if constexpr (SP2) {
        PG8_STAGE(PG8_SB(0, 0), cB, voffB); PG8_STAGE(PG8_SB(0, 1), cB + hstep, voffB); PG8_STAGE(PG8_SA(0, 0), cA, voffA); PG8_STAGE(PG8_SA(0, 1), cA + hstep, voffA);
        if (wr == 1) PG8_BAR;
        PG8_WAIT_V(2); PG8_BAR;
        PG8_STAGE(PG8_SB(1, 0), cB + kstep, voffB); PG8_STAGE(PG8_SA(1, 0), cA + kstep, voffA); PG8_STAGE(PG8_SB(1, 1), cB + hstep + kstep, voffB);
        PG8_WAIT_V(6); PG8_BAR;
    } else {
        PG8_STAGE(PG8_SB(0, 0), cB, voffB); PG8_STAGE(PG8_SA(0, 0), cA, voffA); PG8_STAGE(PG8_SB(0, 1), cB + hstep, voffB); PG8_STAGE(PG8_SA(0, 1), cA + hstep, voffA);
        if (wr == 1) PG8_BAR;
        PG8_WAIT_V(4); PG8_BAR;
        PG8_STAGE(PG8_SB(1, 0), cB + kstep, voffB); PG8_STAGE(PG8_SA(1, 0), cA + kstep, voffA); PG8_STAGE(PG8_SB(1, 1), cB + hstep + kstep, voffB);
        PG8_WAIT_V(6); PG8_BAR;
    }
    for (;;) {
        const bool has_next = S.next(ui + 1, nxt);
        const char* nA = has_next ? (const char*)g.A + (size_t)nxt.pm * tstep : cA; const char* nB = has_next ? (const char*)g.Bt + (size_t)nxt.pn * tstep : cB;
        for (int t = 0; t < nt; t += 2) {
            const bool last = (t == nt - 2);
            const char* a1 = cA + (size_t)(t + 1) * kstep;
            const char* a2 = last ? nA : cA + (size_t)(t + 2) * kstep; const char* b2 = last ? nB : cB + (size_t)(t + 2) * kstep;
            const char* a3 = a2 + kstep; const char* b3 = b2 + kstep;
            if (last && has_next) S.a_ready(nxt);
            if constexpr (SP2) {
            PG8_LDB(B0, 0, 0); PG8_LDB(B1, 0, 1); PG8_SCHED; PG8_LDA(At, 0, 0); PG8_STAGE(PG8_SA(1, 1), a1 + hstep, voffA);
            PG8_WAIT_V(8); PG8_WAIT_L(0); PG8_BAR; PG8_MMA(0, 0, At, B0); PG8_MMA(0, 1, At, B1); PG8_BAR; PG8_SCHED;
            PG8_LDA(At, 0, 1); PG8_STAGE(PG8_SB(0, 0), b2, voffB); PG8_STAGE(PG8_SB(0, 1), b2 + hstep, voffB); PG8_STAGE(PG8_SA(0, 0), a2, voffA);
            PG8_WAIT_V(8); PG8_WAIT_L(0); PG8_BAR; PG8_MMA(1, 0, At, B0); PG8_MMA(1, 1, At, B1); PG8_BAR; PG8_SCHED;
            PG8_LDB(B0, 1, 0); PG8_LDB(B1, 1, 1); PG8_SCHED; PG8_LDA(At, 1, 0); PG8_STAGE(PG8_SA(0, 1), a2 + hstep, voffA);
            PG8_WAIT_V(8); PG8_WAIT_L(0); PG8_BAR; PG8_MMA(0, 0, At, B0); PG8_MMA(0, 1, At, B1); PG8_BAR; PG8_SCHED;
            PG8_LDA(At, 1, 1); PG8_STAGE(PG8_SB(1, 0), b3, voffB); PG8_STAGE(PG8_SB(1, 1), b3 + hstep, voffB); PG8_STAGE(PG8_SA(1, 0), a3, voffA);
            PG8_WAIT_V(8); PG8_WAIT_L(0); PG8_BAR; PG8_MMA(1, 0, At, B0); PG8_MMA(1, 1, At, B1); PG8_BAR; PG8_SCHED;
            } else {
            PG8_LDB(B0, 0, 0); PG8_SCHED; PG8_LDA(At, 0, 0); PG8_STAGE(PG8_SA(1, 1), a1 + hstep, voffA);
            PG8_WAIT_L(8); PG8_BAR; PG8_WAIT_L(0); PG8_MMA(0, 0, At, B0); PG8_BAR; PG8_SCHED;
            PG8_LDB(B1, 0, 1); PG8_STAGE(PG8_SB(0, 0), b2, voffB);
            PG8_BAR; PG8_WAIT_L(0); PG8_MMA(0, 1, At, B1); PG8_BAR;
            PG8_LDA(At, 0, 1); PG8_STAGE(PG8_SA(0, 0), a2, voffA);
            PG8_BAR; PG8_WAIT_L(0); PG8_MMA(1, 0, At, B0); PG8_BAR; PG8_SCHED;
            PG8_STAGE(PG8_SB(0, 1), b2 + hstep, voffB);
            PG8_WAIT_V(6); PG8_BAR; PG8_MMA(1, 1, At, B1); PG8_BAR;
            PG8_LDB(B0, 1, 0); PG8_SCHED; PG8_LDA(At, 1, 0); PG8_STAGE(PG8_SA(0, 1), a2 + hstep, voffA);
            PG8_WAIT_L(8); PG8_BAR; PG8_WAIT_L(0); PG8_MMA(0, 0, At, B0); PG8_BAR; PG8_SCHED;
            PG8_LDB(B1, 1, 1); PG8_STAGE(PG8_SB(1, 0), b3, voffB);
            PG8_BAR; PG8_WAIT_L(0); PG8_MMA(0, 1, At, B1); PG8_BAR;
            PG8_LDA(At, 1, 1); PG8_STAGE(PG8_SA(1, 0), a3, voffA);
            PG8_BAR; PG8_WAIT_L(0); PG8_MMA(1, 0, At, B0); PG8_BAR; PG8_SCHED;
            PG8_STAGE(PG8_SB(1, 1), b3 + hstep, voffB);
            PG8_WAIT_V(6); PG8_BAR; PG8_MMA(1, 1, At, B1); PG8_BAR;
            }
        }
        if constexpr (ALIGN_EPI) { if (wr == 0) PG8_BAR; }
        if constexpr (!Epi::AFTER_DRAIN) { E(acc, cur, wr, wc, fr, fq); S.done(cur); }
        if (!has_next) break;
#pragma unroll
        for (int a = 0; a < 2; ++a)
#pragma unroll
            for (int b = 0; b < 2; ++b)
#pragma unroll
                for (int m = 0; m < 4; ++m)
#pragma unroll
                    for (int n = 0; n < 2; ++n) acc[a][b][m][n] = (f32x4){0.f, 0.f, 0.f, 0.f};
        cur = nxt; cA = nA; cB = nB; ++ui;
        if constexpr (ALIGN_EPI) { if (wr == 1) PG8_BAR; }
    }
    PG8_WAIT_V(0);
    if constexpr (!ALIGN_EPI) { if (wr == 0) PG8_BAR; }
    PG8_BAR;
    if constexpr (Epi::AFTER_DRAIN) { E.fused(acc, cur, wr, wc, fr, fq, lds, wid, lane); S.done(cur); }
#undef PG8_SA
#undef PG8_SB
#undef PG8_STAGE
#undef PG8_LDA
#undef PG8_LDB
#undef PG8_MMA
#undef PG8_WAIT_V
#undef PG8_WAIT_L
#undef PG8_BAR
#undef PG8_SCHED
}
}
namespace moba {
typedef unsigned short bf16;
typedef short bf16x8 __attribute__((ext_vector_type(8)));
typedef short s16x4 __attribute__((ext_vector_type(4)));
typedef float f32x16 __attribute__((ext_vector_type(16)));
typedef float f32x4 __attribute__((ext_vector_type(4)));
typedef unsigned u32x4 __attribute__((ext_vector_type(4)));
constexpr int D = 128, RS = 1024;
constexpr float SCALE = 0.08838834764831845f;
constexpr float THR = 8.f;
constexpr int NW = 8, QBLK = 32, KVBLK = 64, QB = NW * QBLK;
constexpr int SHM_V = KVBLK * D * 2, SHM_K = KVBLK * D * 2;
constexpr int KM_OFF = 2 * SHM_V + 2 * SHM_K + NW * 64 * 4;
constexpr int LDS_BYTES = KM_OFF + 8 * 128 * 4;

#define KSWZ(row, colB) ((row) * 256 + ((colB) ^ (((row) & 7) << 4)))
#define SBAR() __builtin_amdgcn_sched_barrier(0)
__device__ __forceinline__ int v_st(int k, int c) { const int kk = (k & ~0xC) | ((k & 4) << 1) | ((k & 8) >> 1); return ((kk >> 3) * 4 + (c >> 5)) * 512 + ((kk & 7) * 32 + (c & 31)) * 2; }
__device__ __forceinline__ int v_rd_base(int lane) { return ((lane & 3) << 3) | (((lane >> 2) & 3) << 6) | (((lane >> 4) & 1) << 5) | (((lane >> 5) & 1) << 8); }
constexpr int v_rd_off(int d0, int ks, int half) { return d0 * 512 + ks * 4096 + half * 2048; }
__device__ __forceinline__ int crow(int r, int hi) { return (r & 3) + 8 * (r >> 2) + 4 * hi; }
__device__ __forceinline__ unsigned cvtpk(float lo, float hi) {
    unsigned r; asm volatile("v_cvt_pk_bf16_f32 %0, %1, %2" : "=v"(r) : "v"(lo), "v"(hi)); return r;
}
__device__ __forceinline__ bf16x8 load8(const bf16* p) { return *reinterpret_cast<const bf16x8*>(p); }
__device__ __forceinline__ void mask_tile(f32x16& p0, f32x16& p1, int dq) {
    const float NEG = -__builtin_inff();
#pragma unroll
    for (int r = 0; r < 16; ++r) {
        const int c = (r & 3) + 8 * (r >> 2);
        if (dq - c < 0) p0[r] = NEG;
        if (dq - c - 32 < 0) p1[r] = NEG;
    }
}
__device__ __forceinline__ void partialSM(f32x16& p0, f32x16& p1, float& m_reg, float& mn, float& alpha) {
    float pmax = p0[0];
    _Pragma("unroll") for (int r = 1; r < 16; ++r) pmax = fmaxf(pmax, p0[r]);
    _Pragma("unroll") for (int r = 0; r < 16; ++r) pmax = fmaxf(pmax, p1[r]);
    { auto rr = __builtin_amdgcn_permlane32_swap(__float_as_uint(pmax), __float_as_uint(pmax), false, false);
      pmax = fmaxf(__uint_as_float(rr[0]), __uint_as_float(rr[1])); }
    constexpr float C2 = 1.4426950408889634f * SCALE;
    if (__builtin_expect(__all((pmax - m_reg) * SCALE <= THR), 1)) { mn = m_reg; alpha = 1.f; }
    else { mn = fmaxf(m_reg, pmax); alpha = __builtin_amdgcn_exp2f((m_reg - mn) * C2); m_reg = mn; }
    const float mnL = -mn * C2;
    _Pragma("unroll") for (int r = 0; r < 16; ++r) p0[r] = fmaf(p0[r], C2, mnL);
    _Pragma("unroll") for (int r = 0; r < 16; ++r) p1[r] = fmaf(p1[r], C2, mnL);
    _Pragma("unroll") for (int r = 0; r < 16; ++r) p0[r] = __builtin_amdgcn_exp2f(p0[r]);
}
__device__ __forceinline__ void finishSM(f32x16& p0, f32x16& p1, float alpha, float& l_reg, bf16x8& pa0, bf16x8& pa1, bf16x8& pa2, bf16x8& pa3) {
    _Pragma("unroll") for (int r = 0; r < 16; ++r) p1[r] = __builtin_amdgcn_exp2f(p1[r]);
    float ps = 0;
    _Pragma("unroll") for (int r = 0; r < 16; ++r) ps += p0[r];
    _Pragma("unroll") for (int r = 0; r < 16; ++r) ps += p1[r];
    { auto rr = __builtin_amdgcn_permlane32_swap(__float_as_uint(ps), __float_as_uint(ps), false, false);
      ps = __uint_as_float(rr[0]) + __uint_as_float(rr[1]); }
    l_reg = l_reg * alpha + ps;
#define PK4(P, B_, OUT) do { unsigned a0 = cvtpk(P[B_+0], P[B_+1]), a1 = cvtpk(P[B_+2], P[B_+3]);                          \
        unsigned b0 = cvtpk(P[B_+4], P[B_+5]), b1 = cvtpk(P[B_+6], P[B_+7]);                                             \
        auto r0 = __builtin_amdgcn_permlane32_swap(a0, b0, false, false); auto r1 = __builtin_amdgcn_permlane32_swap(a1, b1, false, false); \
        u32x4 w = {r0[0], r1[0], r0[1], r1[1]}; OUT = *reinterpret_cast<bf16x8*>(&w); } while (0)
    PK4(p0, 0, pa0); PK4(p0, 8, pa1); PK4(p1, 0, pa2); PK4(p1, 8, pa3);
#undef PK4
}
template <int KB>
__device__ __forceinline__ void qkt(f32x16& p0, f32x16& p1, const char* K_lds, int r32, int hi, const bf16x8* qr, float b0, const float (&ksm)[5]) {
    { const float bc0 = b0, bc1 = bc0 + ksm[0], bc2 = bc1 + ksm[0], bc3 = bc2 + ksm[0];
      p0[0] = bc0; p0[1] = bc1; p0[2] = bc2; p0[3] = bc3;
#pragma unroll
      for (int g = 1; g < 4; ++g) { p0[4 * g + 0] = bc0 + ksm[g]; p0[4 * g + 1] = bc1 + ksm[g]; p0[4 * g + 2] = bc2 + ksm[g]; p0[4 * g + 3] = bc3 + ksm[g]; }
#pragma unroll
      for (int r = 0; r < 16; ++r) p1[r] = p0[r] + ksm[4]; }
    const char* kb[4];
#pragma unroll
    for (int dd = 0; dd < 4; ++dd) kb[dd] = K_lds + KB * SHM_K + KSWZ(r32, (dd * 16 + hi * 8) * 2);
#pragma unroll
    for (int d0 = 0; d0 < 8; ++d0) { const char* a = kb[d0 & 3] + (d0 >> 2) * 128;
        bf16x8 b0v = *reinterpret_cast<const bf16x8*>(a);
        bf16x8 b1v = *reinterpret_cast<const bf16x8*>(a + 32 * 256);
        p0 = __builtin_amdgcn_mfma_f32_32x32x16_bf16(b0v, qr[d0], p0, 0, 0, 0);
        p1 = __builtin_amdgcn_mfma_f32_32x32x16_bf16(b1v, qr[d0], p1, 0, 0, 0); }
}
template <int VB>
__device__ __forceinline__ void pv_tile(f32x16* o, int vb0, bf16x8 pa0, bf16x8 pa1, bf16x8 pa2, bf16x8 pa3) {
#define TRRD(dst, off) asm volatile("ds_read_b64_tr_b16 %0, %1 offset:%2" : "=&v"(dst) : "v"(vb0), "i"(off) : "memory")
#define PV_D0(d0) do { s16x4 l0, l1, l2, l3, h0, h1, h2, h3; constexpr int b_ = VB * SHM_V + v_rd_off(d0, 0, 0);     \
        TRRD(l0, b_); TRRD(h0, b_ + 2048); TRRD(l1, b_ + 4096); TRRD(h1, b_ + 6144); TRRD(l2, b_ + 8192); TRRD(h2, b_ + 10240); TRRD(l3, b_ + 12288); TRRD(h3, b_ + 14336); \
        asm volatile("s_waitcnt lgkmcnt(0)" ::: "memory"); SBAR();                 \
        o[d0] = __builtin_amdgcn_mfma_f32_32x32x16_bf16(pa0, (bf16x8){l0[0], l0[1], l0[2], l0[3], h0[0], h0[1], h0[2], h0[3]}, o[d0], 0, 0, 0);   \
        o[d0] = __builtin_amdgcn_mfma_f32_32x32x16_bf16(pa1, (bf16x8){l1[0], l1[1], l1[2], l1[3], h1[0], h1[1], h1[2], h1[3]}, o[d0], 0, 0, 0);   \
        o[d0] = __builtin_amdgcn_mfma_f32_32x32x16_bf16(pa2, (bf16x8){l2[0], l2[1], l2[2], l2[3], h2[0], h2[1], h2[2], h2[3]}, o[d0], 0, 0, 0);   \
        o[d0] = __builtin_amdgcn_mfma_f32_32x32x16_bf16(pa3, (bf16x8){l3[0], l3[1], l3[2], l3[3], h3[0], h3[1], h3[2], h3[3]}, o[d0], 0, 0, 0); } while (0)
    PV_D0(0); PV_D0(1); PV_D0(2); PV_D0(3);
#undef PV_D0
#undef TRRD
}

struct BlockRef { const bf16* Q; const bf16* K; const bf16* V; bf16* O; const float* KM; int qb; float ks; };
struct Seam { bf16x8 qr[8]; bf16x8 st_v0, st_v1, st_k0, st_k1; };
#define ROW(p, k0, rr) ((p) + (size_t)((k0) + (rr)) * RS + sc)
#define VMW() asm volatile("s_waitcnt vmcnt(0)" ::: "memory")
#define VMWN(n) asm volatile("s_waitcnt vmcnt(%0)" :: "i"(n) : "memory")
#define SLOAD_H(Kp, Vp, k0) do { S.st_v0 = load8(ROW(Vp, k0, sr)); S.st_v1 = load8(ROW(Vp, k0, 32 + sr));              \
                         S.st_k0 = load8(ROW(Kp, k0, sr)); S.st_k1 = load8(ROW(Kp, k0, 32 + sr)); } while (0)
#define SWRITE_HK(bf) do { *(bf16x8*)(K_lds + (bf) * SHM_K + kws) = S.st_k0; *(bf16x8*)(K_lds + (bf) * SHM_K + kws + 32 * 256) = S.st_k1; } while (0)
#define SWRITE_HV(bf) do { *(bf16x8*)(V_lds + (bf) * SHM_V + vst0) = S.st_v0; *(bf16x8*)(V_lds + (bf) * SHM_V + vst1) = S.st_v1; } while (0)
#define SWRITE_H(bf) do { SWRITE_HV(bf); SWRITE_HK(bf); } while (0)
__device__ __forceinline__ void moba_prime(const BlockRef& cur, char* lds, Seam& S) {
    int tid_ = threadIdx.x; asm volatile("" : "+v"(tid_));
    const int tid = tid_, wid = __builtin_amdgcn_readfirstlane(tid >> 6), lane = tid & 63, r32 = lane & 31, hi = lane >> 5;
    const int sr = tid >> 4, sc = (tid & 15) * 8, kws = KSWZ(sr, sc * 2); char* K_lds = lds + 2 * SHM_V;
    _Pragma("unroll") for (int d0 = 0; d0 < 8; ++d0) S.qr[d0] = load8(cur.Q + (size_t)(wid * QBLK + r32) * RS + d0 * 16 + hi * 8);
    SLOAD_H(cur.K, cur.V, 0); VMW(); SWRITE_HK(0);
    __syncthreads();
}
__device__ __forceinline__ void moba_block(const BlockRef& cur, const BlockRef& nxt, char* lds, Seam& S) {
    int tid_ = threadIdx.x; asm volatile("" : "+v"(tid_));
    const int tid = tid_, wid = __builtin_amdgcn_readfirstlane(tid >> 6), lane = tid & 63, r32 = lane & 31, hi = lane >> 5;
    const int qb = cur.qb, P0 = qb * QB;
    const int NT = 4 * (qb + 1);
    const int qlo = P0 + wid * QBLK, qm = qlo + r32 - 4 * hi;
    char* V_lds = lds; char* K_lds = lds + 2 * SHM_V;
    float* ws = (float*)(lds + 2 * SHM_V + 2 * SHM_K) + wid * 64; float* li_l = ws, * al_l = ws + 32;
    float* KM = (float*)(lds + KM_OFF);
    if (tid < 256) *(f32x4*)(KM + tid * 4) = *(const f32x4*)(cur.KM + (size_t)(tid >> 5) * 1024 + (tid & 31) * 4);
    __syncthreads();
    unsigned selmask;
    {
        float g[7];
#pragma unroll
        for (int n = 0; n < 7; ++n) g[n] = 0.f;
#pragma unroll
        for (int d0 = 0; d0 < 8; ++d0) {
            float qf[8];
#pragma unroll
            for (int j = 0; j < 8; ++j) qf[j] = __uint_as_float(((unsigned)(unsigned short)S.qr[d0][j]) << 16);
#pragma unroll
            for (int n = 0; n < 7; ++n) if (n < qb) {
                const f32x4 k0 = *(const f32x4*)(KM + n * 128 + d0 * 16 + hi * 8), k1 = *(const f32x4*)(KM + n * 128 + d0 * 16 + hi * 8 + 4);
                g[n] += (qf[0] * k0[0] + qf[1] * k0[1]) + (qf[2] * k0[2] + qf[3] * k0[3]) + (qf[4] * k1[0] + qf[5] * k1[1]) + (qf[6] * k1[2] + qf[7] * k1[3]);
            }
        }
#pragma unroll
        for (int n = 0; n < 7; ++n) g[n] += __shfl_xor(g[n], 32);
        if (qb <= 3) selmask = (1u << qb) - 1u;
        else {
            selmask = 0u;
#pragma unroll
            for (int k = 0; k < 3; ++k) {
                int best = 0; float bv = -__builtin_inff();
#pragma unroll
                for (int n = 0; n < 7; ++n) if (n < qb && !((selmask >> n) & 1u) && g[n] > bv) { bv = g[n]; best = n; }
                selmask |= 1u << best;
            }
        }
        selmask |= 1u << qb;
    }
    const float NEGINF = -__builtin_inff();
    float ksm[5];
    { const float k_ = cur.ks; const float mul[5] = {1.f, 8.f, 16.f, 24.f, 32.f};
#pragma unroll
      for (int i = 0; i < 5; ++i) ksm[i] = __uint_as_float(__builtin_amdgcn_readfirstlane(__float_as_uint(k_ * mul[i]))); }
    const float ks = ksm[0];
    float m_reg = -1e30f, l_reg = 0; f32x16 o[4] = {};
    const int sr = tid >> 4, sc = (tid & 15) * 8, vst0 = v_st(sr, sc), vst1 = v_st(32 + sr, sc), kws = KSWZ(sr, sc * 2);
    const int vb0 = (int)(uintptr_t)V_lds + v_rd_base(lane);
    const bf16* Kh = cur.K; const bf16* Vh = cur.V;
#define RESC(a) do { if (__any((a) < 1.f)) { if (hi == 0) al_l[r32] = (a); asm volatile("s_waitcnt lgkmcnt(0)" ::: "memory");              \
                     _Pragma("unroll") for (int d_ = 0; d_ < 4; ++d_) _Pragma("unroll") for (int r = 0; r < 16; ++r) o[d_][r] *= al_l[crow(r, hi)]; } } while (0)
#define KBASE(t) ((t) * KVBLK)
#define B0(t) ((((selmask >> ((t) >> 2)) & 1u) != 0u) ? -ks * (float)(qm - KBASE(t)) : NEGINF)
#define MASKT(P0_, P1_, t) do { const int kb_ = KBASE(t); if (kb_ + KVBLK - 1 > qlo) mask_tile(P0_, P1_, qm - kb_); } while (0)
#define SEAM_K0() do { VMWN(8); SWRITE_HK(0); SBAR(); } while (0)
    f32x16 pA0, pA1, pB0, pB1; float mnA, mnB, alA, alB; bf16x8 pa0, pa1, pa2, pa3;
    SWRITE_HV(0); SBAR();
    SLOAD_H(Kh, Vh, KBASE(1));
    SBAR(); qkt<0>(pA0, pA1, K_lds, r32, hi, S.qr, B0(0), ksm);
    MASKT(pA0, pA1, 0); partialSM(pA0, pA1, m_reg, mnA, alA);
    VMW(); SWRITE_H(1);
    __syncthreads();
#define HALF_STEP(PX0, PX1, mnX, alX, PY0, PY1, alY, t, KB, VB, SB) do {                                                      \
        SBAR(); qkt<KB>(PX0, PX1, K_lds, r32, hi, S.qr, B0(t), ksm);                                                           \
        finishSM(PY0, PY1, alY, l_reg, pa0, pa1, pa2, pa3); SBAR();                                                           \
        if ((t) + 1 < NT) { SLOAD_H(Kh, Vh, KBASE((t) + 1)); SBAR(); }                                                        \
        pv_tile<VB>(o, vb0, pa0, pa1, pa2, pa3); MASKT(PX0, PX1, (t)); partialSM(PX0, PX1, m_reg, mnX, alX);                  \
        __syncthreads();                                                                                                      \
        if ((t) + 1 < NT) { VMW(); SWRITE_H(SB); }                                                                            \
        RESC(alX); __syncthreads(); } while (0)
    for (int t = 1; t + 1 < NT; t += 2) {
        HALF_STEP(pB0, pB1, mnB, alB, pA0, pA1, alA, t, 1, 0, 0);
        HALF_STEP(pA0, pA1, mnA, alA, pB0, pB1, alB, t + 1, 0, 1, 1);
    }
    SBAR(); qkt<1>(pB0, pB1, K_lds, r32, hi, S.qr, B0(NT - 1), ksm); SBAR();
    SLOAD_H(nxt.K, nxt.V, 0); SBAR();
#pragma unroll
    for (int d0 = 0; d0 < 8; ++d0) S.qr[d0] = load8(nxt.Q + (size_t)(wid * QBLK + r32) * RS + d0 * 16 + hi * 8);
    SBAR();
    finishSM(pA0, pA1, alA, l_reg, pa0, pa1, pa2, pa3); SBAR();
    pv_tile<0>(o, vb0, pa0, pa1, pa2, pa3);
    MASKT(pB0, pB1, NT - 1); partialSM(pB0, pB1, m_reg, mnB, alB); __syncthreads(); RESC(alB);
    finishSM(pB0, pB1, alB, l_reg, pa0, pa1, pa2, pa3); SBAR(); pv_tile<1>(o, vb0, pa0, pa1, pa2, pa3);
    SBAR(); SEAM_K0();
    if (hi == 0) li_l[r32] = l_reg; asm volatile("s_waitcnt lgkmcnt(0)" ::: "memory");
    float rli[16];
#pragma unroll
    for (int r = 0; r < 16; ++r) rli[r] = __builtin_amdgcn_rcpf(li_l[crow(r, hi)]);
    bf16* Ow = cur.O + (size_t)(wid * QBLK) * RS;
#pragma unroll
    for (int r = 0; r < 16; ++r) { const int orow = crow(r, hi);
#pragma unroll
        for (int d0 = 0; d0 < 4; ++d0) { const float v = o[d0][r] * rli[r];
            const float vn = __shfl_xor(v, 1);
            if ((r32 & 1) == 0) *(unsigned*)(Ow + (size_t)orow * RS + d0 * 32 + r32) = cvtpk(v, vn); } }
    __syncthreads();
#undef RESC
#undef KBASE
#undef B0
#undef MASKT
#undef SEAM_K0
#undef HALF_STEP
}
#undef ROW
#undef VMW
#undef VMWN
#undef SLOAD_H
#undef SWRITE_HK
#undef SWRITE_HV
#undef SWRITE_H
#undef KSWZ
#undef SBAR
}
#define GAS __attribute__((address_space(1)))
#define LAS __attribute__((address_space(3)))
typedef unsigned short bf16;
typedef unsigned v4u __attribute__((ext_vector_type(4)));
typedef float f32x4 __attribute__((ext_vector_type(4)));
typedef short bf16x8 __attribute__((ext_vector_type(8)));
typedef GAS unsigned gu32;
typedef GAS unsigned long long gu64;
#define RLX_AGENT __ATOMIC_RELAXED, __HIP_MEMORY_SCOPE_AGENT
#define LDS_WAIT() asm volatile("s_waitcnt lgkmcnt(0)" ::: "memory")
#define VM_WAIT() asm volatile("s_waitcnt vmcnt(0)" ::: "memory")
__device__ __forceinline__ unsigned long long rt() { return __builtin_amdgcn_s_memrealtime(); }
__device__ __forceinline__ unsigned f2bf(float f) { unsigned u = __builtin_bit_cast(unsigned, f); return (u + 0x7fffu + ((u >> 16) & 1u)) >> 16; }
__device__ __forceinline__ unsigned pk2(float lo, float hi) { return f2bf(lo) | (f2bf(hi) << 16); }

#define XB_TMO      128
#define XB_XCNT(j)  (256  + 64 * (j))
#define XB_XSUB(j)  (1280 + 64 * (j))
#define XB_XGEN(j)  (2304 + 64 * (j))
#define XB_TOP      3328
#define XB_TOPGEN   3392
#define XCD_BAR_WORDS 3456
#define XB_SPIN_CAP (1u << 18)

__device__ __forceinline__ unsigned xb_ld(unsigned* p)              { return __hip_atomic_load(p, __ATOMIC_RELAXED, __HIP_MEMORY_SCOPE_AGENT); }
__device__ __forceinline__ unsigned xb_add(unsigned* p, unsigned v) { return __hip_atomic_fetch_add(p, v, __ATOMIC_RELAXED, __HIP_MEMORY_SCOPE_AGENT); }
__device__ __forceinline__ unsigned xb_xcc_id() { return (unsigned)__builtin_amdgcn_s_getreg((3 << 11) | 20) & 0xFu; }
#define XB_SPIN(cond, bar) do { unsigned _sp = 0; while (cond) { __builtin_amdgcn_s_sleep(1); \
    if ((++_sp & 255u) == 0u) { if (xb_ld(&(bar)[XB_TMO])) break; if (_sp > XB_SPIN_CAP) { atomicAdd(&(bar)[XB_TMO], 1u); break; } } } } while (0)

struct XcdBarrier {
    unsigned* bar; unsigned x;
    volatile LAS unsigned* st;
};

__device__ __forceinline__ XcdBarrier xcd_barrier_post(unsigned* bar, volatile LAS unsigned* st) {
    XcdBarrier b; b.bar = bar; b.x = xb_xcc_id(); b.st = st;
    if (threadIdx.x == 0) (void)xb_add(&bar[XB_XCNT(b.x)], 1u);
    return b;
}
__device__ __forceinline__ void xcd_barrier_complete(unsigned* bar, unsigned x, unsigned& nloc, unsigned& nx) {
    const unsigned G = gridDim.x * gridDim.y * gridDim.z;
    unsigned sum, cnt, mine, sp = 0u;
    for (;;) {
        sum = 0u; cnt = 0u; mine = 0u;
#pragma nounroll
        for (unsigned j = 0; j < 16; ++j) { const unsigned c = xb_ld(&bar[XB_XCNT(j)]); sum += c; cnt += (c > 0u) ? 1u : 0u; mine = (j == x) ? c : mine; }
        if (sum == G) break;
        __builtin_amdgcn_s_sleep(1);
        if ((++sp & 255u) == 0u) { if (xb_ld(&bar[XB_TMO])) break; if (sp > XB_SPIN_CAP) { atomicAdd(&bar[XB_TMO], 1u); break; } }
    }
    nloc = mine > 0u ? mine : 1u; nx = cnt > 0u ? cnt : 1u;
}

__device__ __forceinline__ void xcd_barrier(const XcdBarrier& b) {
    asm volatile("s_waitcnt vmcnt(0)" ::: "memory");
    __syncthreads();
    if (threadIdx.x == 0) {
        unsigned* bar = b.bar; asm volatile("" : "+s"(bar));
        __builtin_amdgcn_s_waitcnt(0);
        unsigned nloc = b.st[0], nx = b.st[1];
        if (nloc == 0u) { xcd_barrier_complete(bar, b.x, nloc, nx); b.st[0] = nloc; b.st[1] = nx; }
        const unsigned old = xb_add(&bar[XB_XSUB(b.x)], 1u);
        const unsigned gen = old / nloc;
        if (old + 1u == (gen + 1u) * nloc) {
            __builtin_amdgcn_fence(__ATOMIC_RELEASE, "agent");
            asm volatile("s_waitcnt vmcnt(0)" ::: "memory");
            const unsigned og = xb_add(&bar[XB_TOP], 1u);
            const unsigned tg = og / nx;
            if (og + 1u == (tg + 1u) * nx) xb_add(&bar[XB_TOPGEN], 1u);
            else XB_SPIN(xb_ld(&bar[XB_TOPGEN]) == tg, bar);
            __builtin_amdgcn_fence(__ATOMIC_ACQUIRE, "agent");
            xb_add(&bar[XB_XGEN(b.x)], 1u);
            asm volatile("s_waitcnt vmcnt(0)" ::: "memory");
        } else {
            XB_SPIN(xb_ld(&bar[XB_XGEN(b.x)]) == gen, bar);
            __builtin_amdgcn_fence(__ATOMIC_ACQUIRE, "agent");
            asm volatile("s_waitcnt vmcnt(0)" ::: "memory");
        }
    }
    __syncthreads();
}
typedef float f32x2v __attribute__((ext_vector_type(2)));
constexpr int NWAVES = 8;
constexpr int BATCH = 8, SEQ = 2048, DM = 1024, NH = 8, FF = 2816, DEPTH = 4;
constexpr int M = BATCH * SEQ;
constexpr size_t MiB = 1u << 20;
constexpr size_t WS_CTL = 0;
constexpr size_t WS_KSUM = 1 * MiB;
constexpr size_t ZERO_BYTES = 2 * MiB;
constexpr size_t WS_VEC = 2 * MiB;
constexpr size_t WS_STATS = 4 * MiB;
constexpr int V_QKV = 0, V_LIN = 2 * 3072, V_FIN = V_LIN + 2 * 2048, V_TOTAL = V_FIN + 4 * 5632;
constexpr size_t WS_W = 8 * MiB;
constexpr size_t W_QKV = 0, W_WO = W_QKV + 2ull * 3072 * 1024, W_LIN = W_WO + 2ull * 1024 * 1024, W_LOUT = W_LIN + 2ull * 2048 * 1024,
                 W_FIN = W_LOUT + 2ull * 1024 * 1024, W_FOUT = W_FIN + 4ull * 5632 * 1024, W_GA = W_FOUT + 4ull * 1024 * 2816, W_GX = W_GA + 2ull * 8 * 128 * 128,
                 W_END = W_GX + 2ull * 8 * 128 * 128;
constexpr size_t WS_XB16 = 104 * MiB;
constexpr size_t WS_T = 136 * MiB;
constexpr size_t WS_VECP = 264 * MiB;
constexpr size_t WS_END = 266 * MiB;
static_assert(WS_W + W_END * 2 <= WS_XB16, "weights fit");
constexpr int CW_BAR = 1024;

constexpr int RING_OFF = 0, RING_BYTES = 131072;
constexpr int LDSCTL_OFF = RING_BYTES, MISC_OFF = LDSCTL_OFF + 320, SPARE_OFF = RING_BYTES + 1024;
constexpr int LDS_BYTES = 147456;

__device__ __forceinline__ float bf2f(unsigned short b) { return __uint_as_float(((unsigned)b) << 16); }
__device__ __forceinline__ float wave_sum(float v) {
#pragma unroll
    for (int o = 1; o < 64; o <<= 1) v += __shfl_xor(v, o);
    return v;
}

__device__ __forceinline__ int dest_col(int n, int perm) { if (!perm) return n; const int j = n < FF ? n : n - FF; return 256 * (j >> 7) + (n < FF ? 0 : 128) + (j & 127); }
__device__ __forceinline__ void p0_task(const float* W, int K, int N, bf16* WT, const float* gain, const float* lbias, float* cvec, float* bvec, int perm, int task, int lane, int dry) {
    const int nblk = N / 64, kb = task / nblk, nb = task % nblk, k0 = 128 * kb, n = 64 * nb + lane, d = dest_col(n, perm);
    const GAS float* src = (const GAS float*)W + (size_t)k0 * N + n;
    GAS v4u* dst = (GAS v4u*)(WT + (size_t)d * K + k0);
    float cs = 0.f, bs = 0.f;
#pragma unroll
    for (int q4 = 0; q4 < 4; ++q4) {
        float w[32];
#pragma unroll
        for (int i = 0; i < 32; ++i) w[i] = src[(size_t)(q4 * 32 + i) * N];
        if (gain) {
#pragma unroll
            for (int i = 0; i < 32; ++i) { const int k = k0 + q4 * 32 + i; if (cvec) bs = fmaf(lbias[k], w[i], bs); w[i] *= gain[k]; }
        }
#pragma unroll
        for (int c = 0; c < 4; ++c) { v4u o; o.x = pk2(w[8 * c + 0], w[8 * c + 1]); o.y = pk2(w[8 * c + 2], w[8 * c + 3]); o.z = pk2(w[8 * c + 4], w[8 * c + 5]); o.w = pk2(w[8 * c + 6], w[8 * c + 7]);
            if (cvec) { const unsigned ow[4] = {o.x, o.y, o.z, o.w};
#pragma unroll
                for (int e = 0; e < 4; ++e) cs += __uint_as_float(ow[e] << 16) + __uint_as_float(ow[e] & 0xffff0000u); }
            dst[q4 * 4 + c] = o; }
    }
    if (cvec && !dry) { cvec[(size_t)kb * V_TOTAL + d] = cs; bvec[(size_t)kb * V_TOTAL + d] = bs; }
}

struct Args { const float* in[16]; float* out; unsigned char* ws; int ph_lo, ph_hi; };

namespace lru {
constexpr int L_WA = 0, L_WX = 8192, L_XB = 16384, L_XC = L_XB + 33792, L_CMP = L_XC + 32768, L_GT = L_CMP + 2048, L_CW = L_GT + 8192, L_END = L_CW + 2560;
static_assert(L_END <= RING_BYTES, "lru lds");
__device__ __forceinline__ void phase(LAS unsigned char* lds, int vcu, const bf16* xb, const bf16* gate, bf16* hg, const bf16* wta, const bf16* wtx,
                                      const float* conv_w, const float* conv_b, const float* b_a, const float* b_x, const float* lam) {
    typedef float f32x4 __attribute__((ext_vector_type(4)));
    int tid_ = threadIdx.x; asm volatile("" : "+v"(tid_));
    const int tid = tid_, w = __builtin_amdgcn_readfirstlane(tid >> 6), lane = tid & 63, l15 = lane & 15, q = lane >> 4;
    const int b = vcu >> 5, g = (vcu >> 2) & 7, qd = vcu & 3, ch0 = g * 128 + qd * 32;
    { const int n = tid >> 4, ck = tid & 15;
      const v4u va = *(const GAS v4u*)(wta + ((size_t)(g * 128 + qd * 32 + n)) * 128 + ck * 8), vx = *(const GAS v4u*)(wtx + ((size_t)(g * 128 + qd * 32 + n)) * 128 + ck * 8);
      *(LAS v4u*)(lds + L_WA + n * 256 + ((ck ^ (n & 15)) * 16)) = va; *(LAS v4u*)(lds + L_WX + n * 256 + ((ck ^ (n & 15)) * 16)) = vx;
      if (tid < 128) { LAS float* cw = (LAS float*)(lds + L_CW);
#pragma unroll
          for (int tap = 0; tap < 4; ++tap) cw[tap * 128 + tid] = conv_w[tap * 1024 + g * 128 + tid];
          cw[4 * 128 + tid] = conv_b[g * 128 + tid]; } }
    float ba[2], bx[2], la2[2], carry[2];
#pragma unroll
    for (int nt = 0; nt < 2; ++nt) { const int ch = ch0 + nt * 16 + l15; ba[nt] = b_a[ch]; bx[nt] = b_x[ch];
        const float nl = -lam[ch]; const float sp = fmaxf(nl, 0.f) + log1pf(expf(-fabsf(nl)));
        la2[nt] = -8.0f * sp * 1.4426950408889634f; carry[nt] = 0.f; }
    __syncthreads();
    const size_t rowbase = (size_t)b * SEQ;
    v4u sx[5], sg;
#define LRU_ISSUE(cn) do { const int t0n = (cn) * 128;                                                                                   \
        _Pragma("unroll") for (int k = 0; k < 5; ++k) { const int i = tid + 512 * k; const int r = i >> 4, ck = i & 15, tok = t0n - 3 + r;  \
            sx[k] = (v4u){0u, 0u, 0u, 0u};                                                                                                 \
            if (i < 131 * 16 && tok >= 0) sx[k] = *(const GAS v4u*)(xb + (rowbase + tok) * 1024 + g * 128 + ck * 8); }                      \
        sg = *(const GAS v4u*)(gate + (rowbase + t0n + (tid >> 2)) * 1024 + ch0 + (tid & 3) * 8); } while (0)
    LRU_ISSUE(0);
    for (int c = 0; c < SEQ / 128; ++c) {
        const int t0 = c * 128;
#pragma unroll
        for (int k = 0; k < 5; ++k) { const int i = tid + 512 * k; if (i < 131 * 16) *(LAS v4u*)(lds + L_XB + (i >> 4) * 256 + (i & 15) * 16) = sx[k]; }
        *(LAS v4u*)(lds + L_GT + (tid >> 2) * 64 + (tid & 3) * 16) = sg;
        __syncthreads();
        if (c + 1 < SEQ / 128) LRU_ISSUE(c + 1);
        { const int ck = tid & 15; const LAS float* cw = (const LAS float*)(lds + L_CW);
          float wt[4][8], cb[8];
#pragma unroll
          for (int j = 0; j < 8; ++j) { cb[j] = cw[4 * 128 + ck * 8 + j];
#pragma unroll
              for (int tap = 0; tap < 4; ++tap) wt[tap][j] = cw[tap * 128 + ck * 8 + j]; }
#pragma unroll
          for (int i = 0; i < 4; ++i) { const int tok = (tid >> 4) + 32 * i; float a[8];
#pragma unroll
              for (int j = 0; j < 8; ++j) a[j] = cb[j];
#pragma unroll
              for (int tap = 0; tap < 4; ++tap) { const v4u xv = *(const LAS v4u*)(lds + L_XB + (tok + tap) * 256 + ck * 16);
                  const unsigned xw[4] = {xv.x, xv.y, xv.z, xv.w};
#pragma unroll
                  for (int j = 0; j < 4; ++j) { a[2 * j] = fmaf(wt[tap][2 * j], __uint_as_float(xw[j] << 16), a[2 * j]); a[2 * j + 1] = fmaf(wt[tap][2 * j + 1], __uint_as_float(xw[j] & 0xffff0000u), a[2 * j + 1]); } }
              v4u o; o.x = pk2(a[0], a[1]); o.y = pk2(a[2], a[3]); o.z = pk2(a[4], a[5]); o.w = pk2(a[6], a[7]);
              *(LAS v4u*)(lds + L_XC + tok * 256 + ((ck ^ (tok & 15)) * 16)) = o; } }
        __syncthreads();
        f32x4 accR[2], accI[2];
#pragma unroll
        for (int nt = 0; nt < 2; ++nt) { accR[nt] = (f32x4){0.f, 0.f, 0.f, 0.f}; accI[nt] = (f32x4){0.f, 0.f, 0.f, 0.f}; }
#pragma unroll
        for (int s = 0; s < 4; ++s) { const int ck = 4 * s + q;
            const bf16x8 af = *(const LAS bf16x8*)(lds + L_XC + (16 * w + l15) * 256 + ((ck ^ l15) * 16));
#pragma unroll
            for (int nt = 0; nt < 2; ++nt) {
                const bf16x8 bfa = *(const LAS bf16x8*)(lds + L_WA + (nt * 16 + l15) * 256 + ((ck ^ l15) * 16));
                const bf16x8 bfx = *(const LAS bf16x8*)(lds + L_WX + (nt * 16 + l15) * 256 + ((ck ^ l15) * 16));
                accR[nt] = __builtin_amdgcn_mfma_f32_16x16x32_bf16(af, bfa, accR[nt], 0, 0, 0);
                accI[nt] = __builtin_amdgcn_mfma_f32_16x16x32_bf16(af, bfx, accI[nt], 0, 0, 0); } }
        float av[2][4], bv[2][4], Aex[2], Hex[2];
        LAS f32x2v* cmp = (LAS f32x2v*)(lds + L_CMP);
#pragma unroll
        for (int nt = 0; nt < 2; ++nt) { const int cl = qd * 32 + nt * 16 + l15; float A = 1.f, H = 0.f;
#pragma unroll
            for (int i = 0; i < 4; ++i) { const int tok = 16 * w + 4 * q + i;
                const float xcv = bf2f(*(const LAS unsigned short*)(lds + L_XC + tok * 256 + (((cl >> 3) ^ (tok & 15)) * 16) + (cl & 7) * 2));
                const float r = pg8::fast_sigmoid(accR[nt][i] + ba[nt]), ig = pg8::fast_sigmoid(accI[nt][i] + bx[nt]);
                const float a = __builtin_amdgcn_exp2f(la2[nt] * r); const float mult = __builtin_amdgcn_sqrtf(fmaxf(fmaf(-a, a, 1.0f), 0.f));
                av[nt][i] = a; bv[nt][i] = mult * (ig * xcv); H = fmaf(a, H, bv[nt][i]); A *= a; }
            { float Ap = __shfl_up(A, 16), Hp = __shfl_up(H, 16); if (q >= 1) { H = fmaf(A, Hp, H); A *= Ap; } }
            { float Ap = __shfl_up(A, 32), Hp = __shfl_up(H, 32); if (q >= 2) { H = fmaf(A, Hp, H); A *= Ap; } }
            { float Ap = __shfl_up(A, 16), Hp = __shfl_up(H, 16); Aex[nt] = q >= 1 ? Ap : 1.f; Hex[nt] = q >= 1 ? Hp : 0.f; }
            if (q == 3) cmp[w * 32 + nt * 16 + l15] = (f32x2v){A, H}; }
        __syncthreads();
#pragma unroll
        for (int nt = 0; nt < 2; ++nt) { float Ap = 1.f, Hp = 0.f, At = 1.f, Ht = 0.f;
#pragma unroll
            for (int v = 0; v < 8; ++v) { const f32x2v e = cmp[v * 32 + nt * 16 + l15]; Ht = fmaf(e.x, Ht, e.y); At *= e.x; if (v < w) { Hp = Ht; Ap = At; } }
            float h = fmaf(Ap, carry[nt], Hp);
            h = fmaf(Aex[nt], h, Hex[nt]);
#pragma unroll
            for (int i = 0; i < 4; ++i) { const int tok = 16 * w + 4 * q + i; h = fmaf(av[nt][i], h, bv[nt][i]);
                LAS unsigned short* gp = (LAS unsigned short*)(lds + L_GT + tok * 64 + (nt * 16 + l15) * 2);
                *gp = (unsigned short)f2bf(h * bf2f(*gp)); }
            carry[nt] = fmaf(At, carry[nt], Ht); }
        __syncthreads();
        { const int r = tid >> 2, ck = tid & 3; *(GAS v4u*)(hg + (rowbase + t0 + r) * 1024 + ch0 + ck * 8) = *(const LAS v4u*)(lds + L_GT + r * 64 + ck * 16); }
    }
    __syncthreads();
#undef LRU_ISSUE
}
}

__device__ __forceinline__ unsigned long long ld_tbl(LAS unsigned char* lds, int k) {
    const unsigned long long v = *(volatile LAS unsigned long long*)(lds + LDSCTL_OFF + 8 * k);
    return ((unsigned long long)(unsigned)__builtin_amdgcn_readfirstlane((int)(unsigned)(v >> 32)) << 32) | (unsigned long long)(unsigned)__builtin_amdgcn_readfirstlane((int)(unsigned)v);
}
#define INP(k) ((const float*)ld_tbl(lds, (k)))
#define OUTP() ((float*)ld_tbl(lds, 16))
#define WSP() ((unsigned char*)ld_tbl(lds, 17))
#ifndef REPMASK
#define REPMASK 0
#endif
#define REP_A1 ((REPMASK >> 0) & 1 ? 0 : 1)
#define REP_A2 ((REPMASK >> 1) & 1 ? 0 : 1)
#define REP_OUT ((REPMASK >> 2) & 1 ? 0 : 1)
#define REP_F1 ((REPMASK >> 3) & 1 ? 0 : 1)
#define REP_R1 ((REPMASK >> 4) & 1 ? 0 : 1)
#define REP_R2 ((REPMASK >> 5) & 1 ? 0 : 1)
#define REP_P0 ((REPMASK >> 6) & 1 ? 0 : 1)
#define REP_FIN ((REPMASK >> 7) & 1 ? 0 : 1)
#define REP_BAR ((REPMASK >> 8) & 1)
constexpr int NPHASES = 22;
__global__ void __launch_bounds__(NWAVES * 64, 2) mega_fwd(Args args) {
    extern __shared__ __attribute__((aligned(16))) unsigned char lds_raw[];
    LAS unsigned char* lds = (LAS unsigned char*)lds_raw;
    for (int u = threadIdx.x; u < (LDS_BYTES - LDSCTL_OFF) / 4; u += NWAVES * 64) ((LAS unsigned*)(lds + LDSCTL_OFF))[u] = 0u;
    __syncthreads();
    if (threadIdx.x < 18) { const unsigned long long v = threadIdx.x < 16 ? (unsigned long long)args.in[threadIdx.x] : (threadIdx.x == 16 ? (unsigned long long)args.out : (unsigned long long)args.ws);
        *(LAS unsigned long long*)(lds + LDSCTL_OFF + 8 * threadIdx.x) = v; }
    __syncthreads();
    XcdBarrier bar = xcd_barrier_post((unsigned*)(WSP() + WS_CTL) + CW_BAR, (volatile LAS unsigned*)(lds + MISC_OFF) + 8);
    const int lo = args.ph_lo, hi = args.ph_hi;
    int ph = 0;
#define PH_BEGIN if (ph >= lo && ph < hi) { const int G = gridDim.x, bx = blockIdx.x, vcu = (G % 8 == 0) ? (bx % 8) * (G / 8) + bx / 8 : bx; (void)vcu; unsigned char* ws = WSP(); (void)ws;
#define PH_END   if (ph + 1 < hi) { if (ph == 0) { cooperative_groups::this_grid().sync(); } else { xcd_barrier(bar); if (REP_BAR) xcd_barrier(bar); } } } ++ph;

    PH_BEGIN
    {
        const int lane = threadIdx.x & 63, wave = __builtin_amdgcn_readfirstlane(threadIdx.x >> 6);
        const int gw = vcu * NWAVES + wave, NGW = G * NWAVES;
        float* vec = (float*)(ws + WS_VECP); bf16* Wb = (bf16*)(ws + WS_W);
        const float* lng = INP(14); const float* lnb = INP(15);
        constexpr int I_QKV = (1024 / 128) * (3072 / 64), I_SQ = (1024 / 128) * (1024 / 64), I_LIN = (1024 / 128) * (2048 / 64), I_FIN = (1024 / 128) * (5632 / 64), I_FOUT = (2816 / 128) * (1024 / 64), I_GT = 2;
        constexpr int NITEMS = 2 * I_QKV + 2 * I_SQ + 2 * I_LIN + 2 * I_SQ + 4 * I_FIN + 4 * I_FOUT + 32 * I_GT;
        _Pragma("nounroll") for (int rep_ = REP_P0; rep_ < 2; ++rep_) {
        const int dry = (rep_ == 0);
        for (int it = gw; it < NITEMS; it += NGW) {
            int r = it;
            const float* W; int K = 1024, N; bf16* WT; const float* gn = nullptr; const float* lbv = nullptr; float* cv = nullptr; float* bv = nullptr; int perm = 0;
            if (r < 2 * I_QKV) { const int j = r / I_QKV; r -= j * I_QKV; W = INP(1) + (size_t)j * 1024 * 3072; N = 3072; WT = Wb + W_QKV + (size_t)j * 3072 * 1024;
                if (j) { gn = lng + 3 * 1024; lbv = lnb + 3 * 1024; cv = vec + V_QKV + 3072; bv = vec + 8 * V_TOTAL + V_QKV + 3072; } }
            else if ((r -= 2 * I_QKV) < 2 * I_SQ) { const int j = r / I_SQ; r -= j * I_SQ; W = INP(2) + (size_t)j * 1024 * 1024; N = 1024; WT = Wb + W_WO + (size_t)j * 1024 * 1024; }
            else if ((r -= 2 * I_SQ) < 2 * I_LIN) { const int j = r / I_LIN, li = (j == 0) ? 1 : 5; r -= j * I_LIN;
                W = INP(3) + (size_t)j * 1024 * 2048; N = 2048; WT = Wb + W_LIN + (size_t)j * 2048 * 1024; gn = lng + li * 1024; lbv = lnb + li * 1024; cv = vec + V_LIN + j * 2048; bv = vec + 8 * V_TOTAL + V_LIN + j * 2048; }
            else if ((r -= 2 * I_LIN) < 2 * I_SQ) { const int j = r / I_SQ; r -= j * I_SQ; W = INP(11) + (size_t)j * 1024 * 1024; N = 1024; WT = Wb + W_LOUT + (size_t)j * 1024 * 1024; }
            else if ((r -= 2 * I_SQ) < 4 * I_FIN) { const int i = r / I_FIN, li = 2 * i; r -= i * I_FIN;
                W = INP(12) + (size_t)i * 1024 * 5632; N = 5632; WT = Wb + W_FIN + (size_t)i * 5632 * 1024; gn = lng + li * 1024; lbv = lnb + li * 1024; cv = vec + V_FIN + i * 5632; bv = vec + 8 * V_TOTAL + V_FIN + i * 5632; perm = 1; }
            else if ((r -= 4 * I_FIN) < 4 * I_FOUT) { const int i = r / I_FOUT; r -= i * I_FOUT; W = INP(13) + (size_t)i * 2816 * 1024; K = 2816; N = 1024; WT = Wb + W_FOUT + (size_t)i * 1024 * 2816; }
            else { r -= 4 * I_FOUT; const int mat = r / I_GT, which = mat >> 4, jg = mat & 15; r -= mat * I_GT;
                W = INP(which ? 8 : 6) + (size_t)jg * 16384; K = 128; N = 128; WT = Wb + (which ? W_GX : W_GA) + (size_t)jg * 16384; }
            p0_task(W, K, N, WT, gn, lbv, cv, bv, perm, r, lane, dry);
        }
        const float* x = INP(0); bf16* XB16 = (bf16*)(ws + WS_XB16);
        for (int m = gw; m < M; m += NGW) {
            const GAS f32x4* xr = (const GAS f32x4*)(x + (size_t)m * DM) + lane; GAS unsigned long long* o8 = (GAS unsigned long long*)(XB16 + (size_t)m * DM) + lane;
#pragma unroll
            for (int j = 0; j < 4; ++j) { const f32x4 v = xr[64 * j]; o8[64 * j] = (unsigned long long)pk2(v.x, v.y) | ((unsigned long long)pk2(v.z, v.w) << 32); }
        }
        }
    }
    PH_END

#pragma nounroll
    for (int layer_ = 0; layer_ < DEPTH; ++layer_) {
#define LAYER_VARS int layer = layer_; asm volatile("" : "+s"(layer)); const int j = layer >> 1; (void)j; \
        float* stats = (float*)(ws + WS_STATS); bf16* Wb = (bf16*)(ws + WS_W); bf16* XB16 = (bf16*)(ws + WS_XB16); unsigned char* T = ws + WS_T; (void)Wb; (void)XB16; (void)T; \
        const float* st_mix_in = layer ? stats + (size_t)(2 * layer - 1) * M * 8 : nullptr; float* st_mix_out = stats + (size_t)(2 * layer) * M * 8; float* st_ffn_out = stats + (size_t)(2 * layer + 1) * M * 8; \
        (void)st_mix_in; (void)st_mix_out; (void)st_ffn_out;
        if ((layer_ & 1) == 0) {
            PH_BEGIN
            {
                LAYER_VARS
                float* vec = (float*)(ws + WS_VEC); float* ks_l = (float*)(ws + WS_KSUM) + (size_t)j * 64 * 1024;
                pg8::Gemm g{XB16, Wb + W_QKV + (size_t)j * 3072 * 1024, M, 3072, 1024}; pg8::StaticOrder S; S.init(M, 3072, G, bx);
                pg8::EpiIn<0> E{st_mix_in, vec + V_QKV + j * 3072, vec + V_TOTAL + V_QKV + j * 3072, (bf16*)T, ks_l, 0};
#ifndef NO_G0
                _Pragma("nounroll") for (int rep_ = REP_A1; rep_ < 2; ++rep_) { E.dry = (rep_ == 0); pg8::gemm_phase<pg8::EpiIn<0>, pg8::StaticOrder, true, true>(lds + RING_OFF, g, S, E); }
#endif
            }
            PH_END
            PH_BEGIN
            {
                LAYER_VARS
                if (layer == 0) {
                    const float* vp = (const float*)(ws + WS_VECP); float* vf = (float*)(ws + WS_VEC);
                    int tf_ = threadIdx.x; asm volatile("" : "+v"(tf_));
                    for (int col = bx * (NWAVES * 64) + tf_; col < V_TOTAL; col += G * NWAVES * 64) { float c = 0.f, bsum = 0.f;
                        if (col >= 3072) {
#pragma unroll
                            for (int kb = 0; kb < 8; ++kb) { c += vp[(size_t)kb * V_TOTAL + col]; bsum += vp[(size_t)(8 + kb) * V_TOTAL + col]; } }
                        vf[col] = c; vf[V_TOTAL + col] = bsum; }
                }
#ifndef NO_ATTN
                _Pragma("nounroll") for (int rep_ = REP_A2; rep_ < 2; ++rep_)
                if (vcu < 256) {
                    bf16* Qb = (bf16*)T; bf16* Kb = (bf16*)(T + 32 * MiB); bf16* Vb = (bf16*)(T + 64 * MiB); bf16* Ob = (bf16*)(T + 96 * MiB);
                    const float* ks_l = (const float*)(ws + WS_KSUM) + (size_t)j * 64 * 1024;
                    const int bh = vcu >> 2, xq = vcu & 3, b = bh >> 3, h = bh & 7;
                    const float ksl = exp2f(-(float)(h + 1)) / moba::SCALE;
                    const size_t hb = (size_t)b * SEQ * 1024 + (size_t)h * 128;
                    moba::BlockRef cur{Qb + hb + (size_t)xq * 256 * 1024, Kb + hb, Vb + hb, Ob + hb + (size_t)xq * 256 * 1024, ks_l + (size_t)b * 8 * 1024 + h * 128, xq, ksl};
                    moba::Seam S;
                    moba::moba_prime(cur, (char*)lds_raw + RING_OFF, S);
#pragma nounroll
                    for (int pass = 0; pass < 2; ++pass) {
                        moba::BlockRef nxt = cur; nxt.qb = 7 - xq; nxt.Q = Qb + hb + (size_t)(7 - xq) * 256 * 1024; nxt.O = Ob + hb + (size_t)(7 - xq) * 256 * 1024;
                        moba::moba_block(cur, nxt, (char*)lds_raw + RING_OFF, S); cur = nxt; }
                }
#endif
            }
            PH_END
            PH_BEGIN
            {
                LAYER_VARS
                const float* lng = INP(14); const float* lnb = INP(15);
                pg8::Gemm g{(bf16*)(T + 96 * MiB), Wb + W_WO + (size_t)j * 1024 * 1024, M, 1024, 1024}; pg8::StaticOrder S; S.init(M, 1024, G, bx);
                pg8::EpiOut E{INP(0), st_mix_in, layer ? lng + (size_t)(2 * layer - 1) * 1024 : nullptr, layer ? lnb + (size_t)(2 * layer - 1) * 1024 : nullptr, OUTP(), XB16, st_mix_out, 0, (LAS float*)(lds + SPARE_OFF)};
#ifndef NO_GOUT
                _Pragma("nounroll") for (int rep_ = REP_OUT; rep_ < 2; ++rep_) { E.dry = (rep_ == 0); pg8::gemm_phase<pg8::EpiOut, pg8::StaticOrder, true, true>(lds + RING_OFF, g, S, E); }
#endif
            }
            PH_END
        } else {
            PH_BEGIN
            {
                LAYER_VARS
                float* vec = (float*)(ws + WS_VEC);
                pg8::Gemm g{XB16, Wb + W_LIN + (size_t)j * 2048 * 1024, M, 2048, 1024}; pg8::StaticOrder S; S.init(M, 2048, G, bx);
                pg8::EpiIn<1> E{st_mix_in, vec + V_LIN + j * 2048, vec + V_TOTAL + V_LIN + j * 2048, (bf16*)T, nullptr, 0};
#ifndef NO_G1
                _Pragma("nounroll") for (int rep_ = REP_R1; rep_ < 2; ++rep_) { E.dry = (rep_ == 0); pg8::gemm_phase<pg8::EpiIn<1>, pg8::StaticOrder, true, true>(lds + RING_OFF, g, S, E); }
#endif
            }
            PH_END
            PH_BEGIN
            {
                LAYER_VARS
#ifndef NO_LRU
                _Pragma("nounroll") for (int rep_ = REP_R2; rep_ < 2; ++rep_)
                if (vcu < 256)
                    lru::phase(lds + RING_OFF, vcu, (bf16*)T, (bf16*)(T + 32 * MiB), (bf16*)(T + 64 * MiB), Wb + W_GA + (size_t)j * 8 * 16384, Wb + W_GX + (size_t)j * 8 * 16384,
                               INP(4) + (size_t)j * 4 * 1024, INP(5) + (size_t)j * 1024, INP(7) + (size_t)j * 1024, INP(9) + (size_t)j * 1024, INP(10) + (size_t)j * 1024);
#endif
            }
            PH_END
            PH_BEGIN
            {
                LAYER_VARS
                const float* lng = INP(14); const float* lnb = INP(15);
                pg8::Gemm g{(bf16*)(T + 64 * MiB), Wb + W_LOUT + (size_t)j * 1024 * 1024, M, 1024, 1024}; pg8::StaticOrder S; S.init(M, 1024, G, bx);
                pg8::EpiOut E{INP(0), st_mix_in, lng + (size_t)(2 * layer - 1) * 1024, lnb + (size_t)(2 * layer - 1) * 1024, OUTP(), XB16, st_mix_out, 0, (LAS float*)(lds + SPARE_OFF)};
#ifndef NO_GOUT
                _Pragma("nounroll") for (int rep_ = REP_OUT; rep_ < 2; ++rep_) { E.dry = (rep_ == 0); pg8::gemm_phase<pg8::EpiOut, pg8::StaticOrder, true, true>(lds + RING_OFF, g, S, E); }
#endif
            }
            PH_END
        }
        PH_BEGIN
        {
            LAYER_VARS
            float* vec = (float*)(ws + WS_VEC);
            pg8::Gemm g{XB16, Wb + W_FIN + (size_t)layer * 5632 * 1024, M, 5632, 1024}; pg8::StaticOrder S; S.init(M, 5632, G, bx);
            pg8::EpiIn<2> E{st_mix_out, vec + V_FIN + layer * 5632, vec + V_TOTAL + V_FIN + layer * 5632, (bf16*)T, nullptr, 0};
#ifndef NO_G2
            _Pragma("nounroll") for (int rep_ = REP_F1; rep_ < 2; ++rep_) { E.dry = (rep_ == 0); pg8::gemm_phase<pg8::EpiIn<2>, pg8::StaticOrder, true, true>(lds + RING_OFF, g, S, E); }
#endif
        }
        PH_END
        PH_BEGIN
        {
            LAYER_VARS
            const float* lng = INP(14); const float* lnb = INP(15);
            pg8::Gemm g{(bf16*)T, Wb + W_FOUT + (size_t)layer * 1024 * 2816, M, 1024, 2816}; pg8::StaticOrder S; S.init(M, 1024, G, bx);
            pg8::EpiOut E{INP(0), st_mix_out, lng + (size_t)(2 * layer) * 1024, lnb + (size_t)(2 * layer) * 1024, OUTP(), XB16, st_ffn_out, 0, (LAS float*)(lds + SPARE_OFF)};
#ifndef NO_GOUT
            _Pragma("nounroll") for (int rep_ = REP_OUT; rep_ < 2; ++rep_) { E.dry = (rep_ == 0); pg8::gemm_phase<pg8::EpiOut, pg8::StaticOrder, true, true>(lds + RING_OFF, g, S, E); }
#endif
        }
        PH_END
    }
    PH_BEGIN
    {
        const int lane = threadIdx.x & 63, wave = __builtin_amdgcn_readfirstlane(threadIdx.x >> 6);
        const int gw = vcu * NWAVES + wave, NGW = G * NWAVES;
        const float* lg = INP(14) + 7 * 1024; const float* lb = INP(15) + 7 * 1024; float* pre = OUTP();
        f32x4 gv[4], bv[4];
#pragma unroll
        for (int jj = 0; jj < 4; ++jj) { gv[jj] = *((const GAS f32x4*)lg + lane + 64 * jj); bv[jj] = *((const GAS f32x4*)lb + lane + 64 * jj); }
        _Pragma("nounroll") for (int rep_ = REP_FIN; rep_ < 2; ++rep_)
        for (int m = gw; m < M; m += NGW) {
            GAS f32x4* xr = (GAS f32x4*)(pre + (size_t)m * DM) + lane;
            f32x4 v[4]; float s = 0.f;
#if RES16
            { const GAS unsigned long long* x8 = (const GAS unsigned long long*)((const bf16*)(ws + WS_XB16) + (size_t)m * DM) + lane;
              _Pragma("unroll") for (int jj = 0; jj < 4; ++jj) { const unsigned long long w8 = x8[64 * jj]; const unsigned lo_ = (unsigned)w8, hi_ = (unsigned)(w8 >> 32);
                  v[jj] = (f32x4){__uint_as_float(lo_ << 16), __uint_as_float(lo_ & 0xffff0000u), __uint_as_float(hi_ << 16), __uint_as_float(hi_ & 0xffff0000u)}; s += (v[jj].x + v[jj].y) + (v[jj].z + v[jj].w); } }
#else
            _Pragma("unroll") for (int jj = 0; jj < 4; ++jj) { v[jj] = xr[64 * jj]; s += (v[jj].x + v[jj].y) + (v[jj].z + v[jj].w); }
#endif
            const float mean = wave_sum(s) * (1.f / DM); float s2 = 0.f;
#pragma unroll
            for (int jj = 0; jj < 4; ++jj) { v[jj] = v[jj] - mean; s2 += (v[jj].x * v[jj].x + v[jj].y * v[jj].y) + (v[jj].z * v[jj].z + v[jj].w * v[jj].w); }
            const float rstd = 1.f / sqrtf(wave_sum(s2) * (1.f / DM) + 1e-5f);
#pragma unroll
            for (int jj = 0; jj < 4; ++jj) { const f32x4 o_ = v[jj] * rstd * gv[jj] + bv[jj]; if (rep_) xr[64 * jj] = o_; else asm volatile("" :: "v"(o_.x), "v"(o_.y), "v"(o_.z), "v"(o_.w)); }
        }
    }
    PH_END
#undef PH_BEGIN
#undef PH_END
#undef LAYER_VARS
}

extern "C" void kernel_launch(void* const* d_in, const int* in_sizes, int n_in, void* d_out, int out_size, void* d_ws, size_t ws_size, hipStream_t stream) {
    static int grid = 0;
    if (grid == 0) {
        if (n_in != 16 || in_sizes[0] != M * DM || out_size != M * DM || ws_size < WS_END) { fprintf(stderr, "kernel_launch: shape/workspace mismatch (n_in %d, in0 %d, out %d, ws %zu)\n", n_in, n_in > 0 ? in_sizes[0] : -1, out_size, ws_size); grid = -1; return; }
        int dev = 0, cus = 0, per_cu = 0;
        if (hipGetDevice(&dev) != hipSuccess || hipDeviceGetAttribute(&cus, hipDeviceAttributeMultiprocessorCount, dev) != hipSuccess) { fprintf(stderr, "kernel_launch: device query failed\n"); grid = -1; return; }
        if (hipFuncSetAttribute((const void*)mega_fwd, hipFuncAttributeMaxDynamicSharedMemorySize, LDS_BYTES) != hipSuccess) { fprintf(stderr, "kernel_launch: hipFuncSetAttribute failed\n"); grid = -1; return; }
        if (hipOccupancyMaxActiveBlocksPerMultiprocessor(&per_cu, (const void*)mega_fwd, NWAVES * 64, LDS_BYTES) != hipSuccess || per_cu < 1) { fprintf(stderr, "kernel_launch: occupancy query says %d blocks per CU\n", per_cu); grid = -1; (void)hipGetLastError(); return; }
        grid = cus;
        if (grid != 256) fprintf(stderr, "kernel_launch: %d CUs; this kernel is laid out for 256\n", grid);
    }
    if (grid < 0) return;
    if (hipMemsetAsync((char*)d_ws + WS_CTL, 0, ZERO_BYTES, stream) != hipSuccess) { fprintf(stderr, "kernel_launch: memset failed\n"); return; }
    Args a{};
    for (int i = 0; i < 16; ++i) a.in[i] = (const float*)d_in[i];
    a.out = (float*)d_out; a.ws = (unsigned char*)d_ws; a.ph_lo = 0; a.ph_hi = NPHASES;
    void* kargs[] = {&a};
    hipError_t e = hipLaunchCooperativeKernel((const void*)mega_fwd, dim3(grid), dim3(NWAVES * 64), kargs, LDS_BYTES, stream);
    if (e != hipSuccess) fprintf(stderr, "kernel_launch: cooperative launch failed: %s (grid %d)\n", hipGetErrorString(e), grid);
}
```

```cpp
#include <hip/hip_runtime.h>
#include <hip/hip_cooperative_groups.h>
#include <cstdio>
#include <cstdint>
namespace pg8 {
#define PG8_LAS __attribute__((address_space(3)))
typedef unsigned short bf16_t;
typedef short bf16x8 __attribute__((ext_vector_type(8)));
typedef float f32x4 __attribute__((ext_vector_type(4)));
typedef unsigned u32x4 __attribute__((ext_vector_type(4)));
constexpr int BM = 256, BK = 64, HALF = 128, HTB = HALF * BK * 2  , STAGE_BYTES = 8 * HTB, NXCD = 8, WGM = 8;

__host__ __device__ __forceinline__ int lds_byte(int r, int c) { const int st = (r >> 4) * 2 + (c >> 5), rr = r & 15, cc = c & 31, ob = rr * 64 + cc * 2; return st * 1024 + (ob ^ (((ob >> 9) & 1) << 5)); }
__host__ __device__ __forceinline__ void stage_rc(int b, int& R, int& C) { const int st = b / 1024, sb = b % 1024, swz = sb ^ (((sb >> 9) & 1) << 5); R = (st >> 1) * 16 + swz / 64; C = (st & 1) * 32 + (swz % 64) / 2; }
__host__ __device__ __forceinline__ int perm32(int rho) { const int n = rho >> 4, i = rho & 15; return 8 * (i >> 2) + 4 * n + (i & 3); }

struct Unit { int pm, pn; };
struct Gemm { const bf16_t* A; const bf16_t* Bt; int M, N, K; };

struct StaticOrder {
    int nM, nN, nwg, G, c;
    __host__ __device__ void init(int M, int N, int G_, int c_) { nM = M / BM; nN = N / BM; nwg = nM * nN; G = G_; c = c_; }
    __host__ __device__ bool next(int i, Unit& u) const {
        const long L = (long)i * G + c; if (L >= nwg) return false;
        int wgid = (int)L; { const int q = nwg / NXCD, r = nwg % NXCD, xcd = wgid % NXCD, off = wgid / NXCD; wgid = (xcd < r ? xcd * (q + 1) : r * (q + 1) + (xcd - r) * q) + off; }
        const int nig = WGM * nN, gid = wgid / nig, fm = gid * WGM, gsz = (nM - fm) < WGM ? (nM - fm) : WGM;
        u.pm = fm + ((wgid % nig) % gsz); u.pn = (wgid % nig) / gsz; return true;
    }
    __device__ __forceinline__ void a_ready(const Unit&) const {}
    __device__ __forceinline__ void done(const Unit&) const {}
};
__device__ __forceinline__ unsigned cvt_pk_bf16(float lo, float hi) { unsigned r; asm volatile("v_cvt_pk_bf16_f32 %0, %1, %2" : "=v"(r) : "v"(lo), "v"(hi)); return r; }
typedef float f32x2 __attribute__((ext_vector_type(2)));
typedef unsigned u32x2 __attribute__((ext_vector_type(2)));
#ifndef RES16
#define RES16 0
#endif
constexpr float LN_EPS = 1e-5f, DN_ALPHA = 1.6817928305074290f, LOG2E = 1.4426950408889634f;
__device__ __forceinline__ float fast_sigmoid(float x) { return __builtin_amdgcn_rcpf(1.0f + __builtin_amdgcn_exp2f(-x * LOG2E)); }
__device__ __forceinline__ float gelu_tanh(float y) { const float u = 0.7978845608028654f * (y + 0.044715f * y * y * y); return y * fast_sigmoid(2.0f * u); }
__device__ __forceinline__ void row_mu_rs(const float* st, int row, float& mu, float& rs) {
    if (st == nullptr) { mu = 0.f; rs = 1.f; return; }
    const f32x4 a = *(const f32x4*)(st + 8 * (size_t)row), b = *(const f32x4*)(st + 8 * (size_t)row + 4);
    const float sm = (a[0] + a[2]) + (b[0] + b[2]), sq = (a[1] + a[3]) + (b[1] + b[3]);
    mu = sm * (1.0f / 1024.0f); const float var = fmaxf(sq * (1.0f / 1024.0f) - mu * mu, 0.f); rs = __builtin_amdgcn_rsqf(var + LN_EPS);
}

template <int MODE> struct EpiIn {
    static constexpr bool PERM = true, AFTER_DRAIN = false;
    const float* st; const float* cvec; const float* bvec; bf16_t* o0; float* ksum; int dry;
    __device__ __forceinline__ void operator()(const f32x4 (&acc)[2][2][4][2], const Unit& u, int wr, int wc, int fr, int fq) const {
        const int row0 = u.pm * BM + wr * 64 + fr, cl = wc * 32 + 8 * fq, colt = u.pn * BM;
        if (MODE == 2) {
            f32x4 cg[2], cu[2], bg[2], bu[2];
#pragma unroll
            for (int n = 0; n < 2; ++n) { cg[n] = *(const f32x4*)(cvec + colt + cl + 4 * n); cu[n] = *(const f32x4*)(cvec + colt + HALF + cl + 4 * n);
                bg[n] = *(const f32x4*)(bvec + colt + cl + 4 * n); bu[n] = *(const f32x4*)(bvec + colt + HALF + cl + 4 * n); }
#pragma unroll
            for (int ai = 0; ai < 2; ++ai)
#pragma unroll
                for (int m = 0; m < 4; ++m) {
                    float mu, rs; row_mu_rs(st, row0 + ai * HALF + m * 16, mu, rs);
                    unsigned wv[4];
#pragma unroll
                    for (int n = 0; n < 2; ++n) {
                        const f32x4 g = (acc[ai][0][m][n] - mu * cg[n]) * rs + bg[n], uu = (acc[ai][1][m][n] - mu * cu[n]) * rs + bu[n];
                        float a[4];
#pragma unroll
                        for (int j = 0; j < 4; ++j) a[j] = g[j] * fast_sigmoid(g[j]) * uu[j];
                        wv[2 * n] = cvt_pk_bf16(a[0], a[1]); wv[2 * n + 1] = cvt_pk_bf16(a[2], a[3]);
                    }
                    const u32x4 w = {wv[0], wv[1], wv[2], wv[3]};
                    if (!dry) *(u32x4*)(o0 + (size_t)(row0 + ai * HALF + m * 16) * 2816 + u.pn * HALF + cl) = w; else asm volatile("" :: "v"(w.x), "v"(w.y), "v"(w.z), "v"(w.w));
                }
        } else {
            bf16_t* base; const int ocol = (u.pn & 3) * BM;
            base = o0 + (size_t)(u.pn >> 2) * ((size_t)16384 * 1024);
            const bool is_k = (MODE == 0) && ((u.pn >> 2) == 1), is_gate = (MODE == 1) && (u.pn >= 4);
#pragma unroll
            for (int bj = 0; bj < 2; ++bj) {
                const f32x4 c0 = *(const f32x4*)(cvec + colt + bj * HALF + cl), c1 = *(const f32x4*)(cvec + colt + bj * HALF + cl + 4);
                const f32x4 b0 = *(const f32x4*)(bvec + colt + bj * HALF + cl), b1 = *(const f32x4*)(bvec + colt + bj * HALF + cl + 4);
                f32x4 s0 = {0.f, 0.f, 0.f, 0.f}, s1 = {0.f, 0.f, 0.f, 0.f};
#pragma unroll
                for (int ai = 0; ai < 2; ++ai)
#pragma unroll
                    for (int m = 0; m < 4; ++m) {
                        float mu, rs; row_mu_rs(st, row0 + ai * HALF + m * 16, mu, rs);
                        f32x4 v0 = (acc[ai][bj][m][0] - mu * c0) * rs + b0, v1 = (acc[ai][bj][m][1] - mu * c1) * rs + b1;
                        if (MODE == 0) { s0 += v0; s1 += v1; }
                        if (MODE == 1 && is_gate) {
#pragma unroll
                            for (int j = 0; j < 4; ++j) { v0[j] = gelu_tanh(v0[j]); v1[j] = gelu_tanh(v1[j]); }
                        }
                        u32x4 w; w.x = cvt_pk_bf16(v0[0], v0[1]); w.y = cvt_pk_bf16(v0[2], v0[3]); w.z = cvt_pk_bf16(v1[0], v1[1]); w.w = cvt_pk_bf16(v1[2], v1[3]);
                        if (!dry) *(u32x4*)(base + (size_t)(row0 + ai * HALF + m * 16) * 1024 + ocol + bj * HALF + cl) = w; else asm volatile("" :: "v"(w.x), "v"(w.y), "v"(w.z), "v"(w.w));
                    }
                if (MODE == 0 && is_k) {
                    float t0 = s0[0], t1 = s0[1], t2 = s0[2], t3 = s0[3], t4 = s1[0], t5 = s1[1], t6 = s1[2], t7 = s1[3];
#define RED16(v) v += __shfl_xor(v, 1); v += __shfl_xor(v, 2); v += __shfl_xor(v, 4); v += __shfl_xor(v, 8)
                    RED16(t0); RED16(t1); RED16(t2); RED16(t3); RED16(t4); RED16(t5); RED16(t6); RED16(t7);
#undef RED16
                    if (fr == 0 && !dry) { float* kp = ksum + (size_t)u.pm * 1024 + ocol + bj * HALF + cl;
                        atomicAdd(kp + 0, t0); atomicAdd(kp + 1, t1); atomicAdd(kp + 2, t2); atomicAdd(kp + 3, t3);
                        atomicAdd(kp + 4, t4); atomicAdd(kp + 5, t5); atomicAdd(kp + 6, t6); atomicAdd(kp + 7, t7); }
                }
            }
        }
    }
};

__device__ __forceinline__ f32x4 bfpair_lo(unsigned a, unsigned b) { return (f32x4){__uint_as_float(a << 16), __uint_as_float(a & 0xffff0000u), __uint_as_float(b << 16), __uint_as_float(b & 0xffff0000u)}; }
struct EpiOut {
    static constexpr bool PERM = true, AFTER_DRAIN = false;
    const float* st_in; const float* lg; const float* lb; bf16_t* hi16; bf16_t* lo16; float* st_out; int dry; PG8_LAS float* sp;
    __device__ __forceinline__ void operator()(const f32x4 (&acc)[2][2][4][2], const Unit& u, int wr, int wc, int fr, int fq) const {
        const int row0 = u.pm * BM + wr * 64 + fr, col0 = u.pn * BM + wc * 32 + 8 * fq;
        const bool ln = st_in != nullptr;
        u32x4 nh[2], nl[2]; f32x4 nsa = {0.f, 0.f, 0.f, 0.f}, nsb = nsa;
        { const size_t off = (size_t)row0 * 1024 + col0;
          nh[0] = *(const u32x4*)(hi16 + off); nh[1] = *(const u32x4*)(hi16 + off + HALF); nl[0] = *(const u32x4*)(lo16 + off); nl[1] = *(const u32x4*)(lo16 + off + HALF);
          if (ln) { nsa = *(const f32x4*)(st_in + 8 * (size_t)row0); nsb = *(const f32x4*)(st_in + 8 * (size_t)row0 + 4); } }
#pragma unroll
        for (int i = 0; i < 8; ++i) {
            const int ai = i >> 2, m = i & 3, row = row0 + ai * HALF + m * 16;
            const float csm = (nsa[0] + nsa[2]) + (nsb[0] + nsb[2]), csq = (nsa[1] + nsa[3]) + (nsb[1] + nsb[3]);
            f32x4 cx[4];
#pragma unroll
            for (int bj = 0; bj < 2; ++bj) { cx[2 * bj] = bfpair_lo(nh[bj].x, nh[bj].y) + bfpair_lo(nl[bj].x, nl[bj].y); cx[2 * bj + 1] = bfpair_lo(nh[bj].z, nh[bj].w) + bfpair_lo(nl[bj].z, nl[bj].w); }
            if (i + 1 < 8) { const int rown = row0 + ((i + 1) >> 2) * HALF + ((i + 1) & 3) * 16; const size_t offn = (size_t)rown * 1024 + col0;
                nh[0] = *(const u32x4*)(hi16 + offn); nh[1] = *(const u32x4*)(hi16 + offn + HALF); nl[0] = *(const u32x4*)(lo16 + offn); nl[1] = *(const u32x4*)(lo16 + offn + HALF);
                if (ln) { nsa = *(const f32x4*)(st_in + 8 * (size_t)rown); nsb = *(const f32x4*)(st_in + 8 * (size_t)rown + 4); } }
            float mu = 0.f, rs = 1.f;
            if (ln) { mu = csm * (1.0f / 1024.0f); const float var = fmaxf(csq * (1.0f / 1024.0f) - mu * mu, 0.f); rs = __builtin_amdgcn_rsqf(var + LN_EPS); }
            float s = 0.f, q = 0.f;
#pragma unroll
            for (int bj = 0; bj < 2; ++bj) {
                f32x4 g0 = {1.f, 1.f, 1.f, 1.f}, g1 = g0, b0 = {0.f, 0.f, 0.f, 0.f}, b1 = b0;
                if (ln) { g0 = *(const f32x4*)(lg + col0 + bj * HALF); g1 = *(const f32x4*)(lg + col0 + bj * HALF + 4); b0 = *(const f32x4*)(lb + col0 + bj * HALF); b1 = *(const f32x4*)(lb + col0 + bj * HALF + 4); }
                const size_t off = (size_t)row * 1024 + col0 + bj * HALF;
                const f32x4 v0 = ((cx[2 * bj] - mu) * rs * g0 + b0) * DN_ALPHA + acc[ai][bj][m][0], v1 = ((cx[2 * bj + 1] - mu) * rs * g1 + b1) * DN_ALPHA + acc[ai][bj][m][1];
                u32x4 w; w.x = cvt_pk_bf16(v0[0], v0[1]); w.y = cvt_pk_bf16(v0[2], v0[3]); w.z = cvt_pk_bf16(v1[0], v1[1]); w.w = cvt_pk_bf16(v1[2], v1[3]);
                const f32x4 r0 = v0 - bfpair_lo(w.x, w.y), r1 = v1 - bfpair_lo(w.z, w.w);
                u32x4 wl; wl.x = cvt_pk_bf16(r0[0], r0[1]); wl.y = cvt_pk_bf16(r0[2], r0[3]); wl.z = cvt_pk_bf16(r1[0], r1[1]); wl.w = cvt_pk_bf16(r1[2], r1[3]);
                if (!dry) { *(u32x4*)(hi16 + off) = w; *(u32x4*)(lo16 + off) = wl; } else asm volatile("" :: "v"(w.x), "v"(w.y), "v"(w.z), "v"(w.w), "v"(wl.x), "v"(wl.y), "v"(wl.z), "v"(wl.w));
                s += ((v0[0] + v0[1]) + (v0[2] + v0[3])) + ((v1[0] + v1[1]) + (v1[2] + v1[3]));
                q += ((v0[0] * v0[0] + v0[1] * v0[1]) + (v0[2] * v0[2] + v0[3] * v0[3])) + ((v1[0] * v1[0] + v1[1] * v1[1]) + (v1[2] * v1[2] + v1[3] * v1[3]));
            }
            s += __shfl_xor(s, 16); s += __shfl_xor(s, 32); q += __shfl_xor(q, 16); q += __shfl_xor(q, 32);
            if (fq == 0) *(PG8_LAS f32x2*)(sp + ((ai * HALF + wr * 64 + m * 16 + fr) * 4 + wc) * 2) = (f32x2){s, q};
        }
        asm volatile("s_waitcnt lgkmcnt(0)" ::: "memory"); __builtin_amdgcn_s_barrier(); asm volatile("" ::: "memory");
        { const int t = wr * 256 + wc * 64 + fq * 16 + fr;
          if (t < 256 && !dry) { const f32x4 a = *(const PG8_LAS f32x4*)(sp + t * 8), b = *(const PG8_LAS f32x4*)(sp + t * 8 + 4);
              *(f32x2*)(st_out + 8 * (size_t)(u.pm * BM + t) + 2 * u.pn) = (f32x2){(a[0] + a[2]) + (b[0] + b[2]), (a[1] + a[3]) + (b[1] + b[3])}; } }
        asm volatile("s_waitcnt lgkmcnt(0)" ::: "memory"); __builtin_amdgcn_s_barrier(); asm volatile("" ::: "memory");
    }
};
template <class Epi, class Sched, bool ALIGN_EPI = false, bool SP2 = false>
__device__ __forceinline__ void gemm_phase(PG8_LAS unsigned char* lds, const Gemm g, const Sched& S, const Epi& E) {
    int tid_ = threadIdx.x; asm volatile("" : "+v"(tid_));
    const int tid = tid_, wid = __builtin_amdgcn_readfirstlane(tid >> 6), lane = tid & 63, wr = wid >> 2, wc = wid & 3, fr = lane & 15, fq = lane >> 4;
    const int K = g.K, nt = K / BK;
    unsigned voffA[2], voffB[2];
#pragma unroll
    for (int i = 0; i < 2; ++i) { int R, C; stage_rc(tid * 16 + i * 8192, R, C); const int Rb = Epi::PERM ? ((R & ~31) + perm32(R & 31)) : R;
        voffA[i] = (unsigned)(R * K + C) * 2u; voffB[i] = (unsigned)(Rb * K + C) * 2u; }
    const size_t kstep = (size_t)(BK * 2);
    const size_t hstep = (size_t)HALF * K * 2;
    const size_t tstep = 2 * hstep;
    const unsigned ldsw = (unsigned)wid * 1024u;
    const int aoff = lds_byte(wr * 64 + fr, fq * 8), boff = lds_byte(wc * 32 + fr, fq * 8);
#define PG8_SA(b, h) (((b) * 2 + (h)) * HTB)
#define PG8_SB(b, h) ((4 + (b) * 2 + (h)) * HTB)
#define PG8_STAGE(bufoff, gbase, voff) do { _Pragma("unroll") for (int _i = 0; _i < 2; ++_i) \
        __builtin_amdgcn_global_load_lds((const unsigned*)((const char*)(gbase) + (voff)[_i]), (PG8_LAS unsigned*)(lds + (bufoff) + ldsw + _i * 8192), 16, 0, 0); } while (0)
#define PG8_LDA(dst, b, h) do { _Pragma("unroll") for (int m = 0; m < 4; ++m) _Pragma("unroll") for (int k = 0; k < 2; ++k) dst[m][k] = *(const PG8_LAS bf16x8*)(lds + PG8_SA(b, h) + aoff + m * 2048 + k * 1024); } while (0)
#define PG8_LDB(dst, b, h) do { _Pragma("unroll") for (int n = 0; n < 2; ++n) _Pragma("unroll") for (int k = 0; k < 2; ++k) dst[n][k] = *(const PG8_LAS bf16x8*)(lds + PG8_SB(b, h) + boff + n * 2048 + k * 1024); } while (0)
#define PG8_MMA(ai, bj, At, Bt) do { __builtin_amdgcn_s_setprio(1); _Pragma("unroll") for (int m = 0; m < 4; ++m) _Pragma("unroll") for (int n = 0; n < 2; ++n) _Pragma("unroll") for (int k = 0; k < 2; ++k) \
        acc[ai][bj][m][n] = __builtin_amdgcn_mfma_f32_16x16x32_bf16(Bt[n][k], At[m][k], acc[ai][bj][m][n], 0, 0, 0); __builtin_amdgcn_s_setprio(0); } while (0)
#define PG8_WAIT_V(n) asm volatile("s_waitcnt vmcnt(" #n ")" ::: "memory")
#define PG8_WAIT_L(n) asm volatile("s_waitcnt lgkmcnt(" #n ")" ::: "memory")
#define PG8_BAR __builtin_amdgcn_s_barrier()
#define PG8_SCHED __builtin_amdgcn_sched_barrier(0)
    Unit cur, nxt; int ui = 0;
    if (!S.next(0, cur)) return;
    f32x4 acc[2][2][4][2];
#pragma unroll
    for (int a = 0; a < 2; ++a)
#pragma unroll
        for (int b = 0; b < 2; ++b)
#pragma unroll
            for (int m = 0; m < 4; ++m)
#pragma unroll
                for (int n = 0; n < 2; ++n) acc[a][b][m][n] = (f32x4){0.f, 0.f, 0.f, 0.f};
    bf16x8 At[4][2], B0[2][2], B1[2][2];
    const char* cA = (const char*)g.A + (size_t)cur.pm * tstep; const char* cB = (const char*)g.Bt + (size_t)cur.pn * tstep;
    S.a_ready(cur);
    if constexpr (SP2) {
        PG8_STAGE(PG8_SB(0, 0), cB, voffB); PG8_STAGE(PG8_SB(0, 1), cB + hstep, voffB); PG8_STAGE(PG8_SA(0, 0), cA, voffA); PG8_STAGE(PG8_SA(0, 1), cA + hstep, voffA);
        if (wr == 1) PG8_BAR;
        PG8_WAIT_V(2); PG8_BAR;
        PG8_STAGE(PG8_SB(1, 0), cB + kstep, voffB); PG8_STAGE(PG8_SA(1, 0), cA + kstep, voffA); PG8_STAGE(PG8_SB(1, 1), cB + hstep + kstep, voffB);
        PG8_WAIT_V(6); PG8_BAR;
    } else {
        PG8_STAGE(PG8_SB(0, 0), cB, voffB); PG8_STAGE(PG8_SA(0, 0), cA, voffA); PG8_STAGE(PG8_SB(0, 1), cB + hstep, voffB); PG8_STAGE(PG8_SA(0, 1), cA + hstep, voffA);
        if (wr == 1) PG8_BAR;
        PG8_WAIT_V(4); PG8_BAR;
        PG8_STAGE(PG8_SB(1, 0), cB + kstep, voffB); PG8_STAGE(PG8_SA(1, 0), cA + kstep, voffA); PG8_STAGE(PG8_SB(1, 1), cB + hstep + kstep, voffB);
        PG8_WAIT_V(6); PG8_BAR;
    }
    for (;;) {
        const bool has_next = S.next(ui + 1, nxt);
        const char* nA = has_next ? (const char*)g.A + (size_t)nxt.pm * tstep : cA; const char* nB = has_next ? (const char*)g.Bt + (size_t)nxt.pn * tstep : cB;
        for (int t = 0; t < nt; t += 2) {
            const bool last = (t == nt - 2);
            const char* a1 = cA + (size_t)(t + 1) * kstep;
            const char* a2 = last ? nA : cA + (size_t)(t + 2) * kstep; const char* b2 = last ? nB : cB + (size_t)(t + 2) * kstep;
            const char* a3 = a2 + kstep; const char* b3 = b2 + kstep;
            if (last && has_next) S.a_ready(nxt);
            if constexpr (SP2) {
            PG8_LDB(B0, 0, 0); PG8_LDB(B1, 0, 1); PG8_SCHED; PG8_LDA(At, 0, 0); PG8_STAGE(PG8_SA(1, 1), a1 + hstep, voffA);
            PG8_WAIT_V(8); PG8_WAIT_L(0); PG8_BAR; PG8_MMA(0, 0, At, B0); PG8_MMA(0, 1, At, B1); PG8_BAR; PG8_SCHED;
            PG8_LDA(At, 0, 1); PG8_STAGE(PG8_SB(0, 0), b2, voffB); PG8_STAGE(PG8_SB(0, 1), b2 + hstep, voffB); PG8_STAGE(PG8_SA(0, 0), a2, voffA);
            PG8_WAIT_V(8); PG8_WAIT_L(0); PG8_BAR; PG8_MMA(1, 0, At, B0); PG8_MMA(1, 1, At, B1); PG8_BAR; PG8_SCHED;
            PG8_LDB(B0, 1, 0); PG8_LDB(B1, 1, 1); PG8_SCHED; PG8_LDA(At, 1, 0); PG8_STAGE(PG8_SA(0, 1), a2 + hstep, voffA);
            PG8_WAIT_V(8); PG8_WAIT_L(0); PG8_BAR; PG8_MMA(0, 0, At, B0); PG8_MMA(0, 1, At, B1); PG8_BAR; PG8_SCHED;
            PG8_LDA(At, 1, 1); PG8_STAGE(PG8_SB(1, 0), b3, voffB); PG8_STAGE(PG8_SB(1, 1), b3 + hstep, voffB); PG8_STAGE(PG8_SA(1, 0), a3, voffA);
            PG8_WAIT_V(8); PG8_WAIT_L(0); PG8_BAR; PG8_MMA(1, 0, At, B0); PG8_MMA(1, 1, At, B1); PG8_BAR; PG8_SCHED;
            } else {
            PG8_LDB(B0, 0, 0); PG8_SCHED; PG8_LDA(At, 0, 0); PG8_STAGE(PG8_SA(1, 1), a1 + hstep, voffA);
            PG8_WAIT_L(8); PG8_BAR; PG8_WAIT_L(0); PG8_MMA(0, 0, At, B0); PG8_BAR; PG8_SCHED;
            PG8_LDB(B1, 0, 1); PG8_STAGE(PG8_SB(0, 0), b2, voffB);
            PG8_BAR; PG8_WAIT_L(0); PG8_MMA(0, 1, At, B1); PG8_BAR;
            PG8_LDA(At, 0, 1); PG8_STAGE(PG8_SA(0, 0), a2, voffA);
            PG8_BAR; PG8_WAIT_L(0); PG8_MMA(1, 0, At, B0); PG8_BAR; PG8_SCHED;
            PG8_STAGE(PG8_SB(0, 1), b2 + hstep, voffB);
            PG8_WAIT_V(6); PG8_BAR; PG8_MMA(1, 1, At, B1); PG8_BAR;
            PG8_LDB(B0, 1, 0); PG8_SCHED; PG8_LDA(At, 1, 0); PG8_STAGE(PG8_SA(0, 1), a2 + hstep, voffA);
            PG8_WAIT_L(8); PG8_BAR; PG8_WAIT_L(0); PG8_MMA(0, 0, At, B0); PG8_BAR; PG8_SCHED;
            PG8_LDB(B1, 1, 1); PG8_STAGE(PG8_SB(1, 0), b3, voffB);
            PG8_BAR; PG8_WAIT_L(0); PG8_MMA(0, 1, At, B1); PG8_BAR;
            PG8_LDA(At, 1, 1); PG8_STAGE(PG8_SA(1, 0), a3, voffA);
            PG8_BAR; PG8_WAIT_L(0); PG8_MMA(1, 0, At, B0); PG8_BAR; PG8_SCHED;
            PG8_STAGE(PG8_SB(1, 1), b3 + hstep, voffB);
            PG8_WAIT_V(6); PG8_BAR; PG8_MMA(1, 1, At, B1); PG8_BAR;
            }
        }
        if constexpr (ALIGN_EPI) { if (wr == 0) PG8_BAR; }
        if constexpr (!Epi::AFTER_DRAIN) { E(acc, cur, wr, wc, fr, fq); S.done(cur); }
        if (!has_next) break;
#pragma unroll
        for (int a = 0; a < 2; ++a)
#pragma unroll
            for (int b = 0; b < 2; ++b)
#pragma unroll
                for (int m = 0; m < 4; ++m)
#pragma unroll
                    for (int n = 0; n < 2; ++n) acc[a][b][m][n] = (f32x4){0.f, 0.f, 0.f, 0.f};
        cur = nxt; cA = nA; cB = nB; ++ui;
        if constexpr (ALIGN_EPI) { if (wr == 1) PG8_BAR; }
    }
    PG8_WAIT_V(0);
    if constexpr (!ALIGN_EPI) { if (wr == 0) PG8_BAR; }
    PG8_BAR;
    if constexpr (Epi::AFTER_DRAIN) { E.fused(acc, cur, wr, wc, fr, fq, lds, wid, lane); S.done(cur); }
#undef PG8_SA
#undef PG8_SB
#undef PG8_STAGE
#undef PG8_LDA
#undef PG8_LDB
#undef PG8_MMA
#undef PG8_WAIT_V
#undef PG8_WAIT_L
#undef PG8_BAR
#undef PG8_SCHED
}
}
namespace moba {
typedef unsigned short bf16;
typedef short bf16x8 __attribute__((ext_vector_type(8)));
typedef short s16x4 __attribute__((ext_vector_type(4)));
typedef float f32x16 __attribute__((ext_vector_type(16)));
typedef float f32x4 __attribute__((ext_vector_type(4)));
typedef unsigned u32x4 __attribute__((ext_vector_type(4)));
constexpr int D = 128, RS = 1024;
constexpr float SCALE = 0.08838834764831845f;
constexpr float THR = 8.f;
constexpr int NW = 8, QBLK = 32, KVBLK = 64, QB = NW * QBLK;
constexpr int SHM_V = KVBLK * D * 2, SHM_K = KVBLK * D * 2;
constexpr int KM_OFF = 2 * SHM_V + 2 * SHM_K + NW * 64 * 4;
constexpr int LDS_BYTES = KM_OFF + 8 * 128 * 4;

#define KSWZ(row, colB) ((row) * 256 + ((colB) ^ (((row) & 7) << 4)))
#define SBAR() __builtin_amdgcn_sched_barrier(0)
__device__ __forceinline__ int v_st(int k, int c) { const int kk = (k & ~0xC) | ((k & 4) << 1) | ((k & 8) >> 1); return ((kk >> 3) * 4 + (c >> 5)) * 512 + ((kk & 7) * 32 + (c & 31)) * 2; }
__device__ __forceinline__ int v_rd_base(int lane) { return ((lane & 3) << 3) | (((lane >> 2) & 3) << 6) | (((lane >> 4) & 1) << 5) | (((lane >> 5) & 1) << 8); }
constexpr int v_rd_off(int d0, int ks, int half) { return d0 * 512 + ks * 4096 + half * 2048; }
__device__ __forceinline__ int crow(int r, int hi) { return (r & 3) + 8 * (r >> 2) + 4 * hi; }
__device__ __forceinline__ unsigned cvtpk(float lo, float hi) {
    unsigned r; asm volatile("v_cvt_pk_bf16_f32 %0, %1, %2" : "=v"(r) : "v"(lo), "v"(hi)); return r;
}
__device__ __forceinline__ bf16x8 load8(const bf16* p) { return *reinterpret_cast<const bf16x8*>(p); }
__device__ __forceinline__ void mask_tile(f32x16& p0, f32x16& p1, int dq) {
    const float NEG = -__builtin_inff();
#pragma unroll
    for (int r = 0; r < 16; ++r) {
        const int c = (r & 3) + 8 * (r >> 2);
        if (dq - c < 0) p0[r] = NEG;
        if (dq - c - 32 < 0) p1[r] = NEG;
    }
}
__device__ __forceinline__ void partialSM(f32x16& p0, f32x16& p1, float& m_reg, float& mn, float& alpha) {
    float pmax = p0[0];
    _Pragma("unroll") for (int r = 1; r < 16; ++r) pmax = fmaxf(pmax, p0[r]);
    _Pragma("unroll") for (int r = 0; r < 16; ++r) pmax = fmaxf(pmax, p1[r]);
    { auto rr = __builtin_amdgcn_permlane32_swap(__float_as_uint(pmax), __float_as_uint(pmax), false, false);
      pmax = fmaxf(__uint_as_float(rr[0]), __uint_as_float(rr[1])); }
    constexpr float C2 = 1.4426950408889634f * SCALE;
    if (__builtin_expect(__all((pmax - m_reg) * SCALE <= THR), 1)) { mn = m_reg; alpha = 1.f; }
    else { mn = fmaxf(m_reg, pmax); alpha = __builtin_amdgcn_exp2f((m_reg - mn) * C2); m_reg = mn; }
    const float mnL = -mn * C2;
    _Pragma("unroll") for (int r = 0; r < 16; ++r) p0[r] = fmaf(p0[r], C2, mnL);
    _Pragma("unroll") for (int r = 0; r < 16; ++r) p1[r] = fmaf(p1[r], C2, mnL);
    _Pragma("unroll") for (int r = 0; r < 16; ++r) p0[r] = __builtin_amdgcn_exp2f(p0[r]);
}
__device__ __forceinline__ void finishSM(f32x16& p0, f32x16& p1, float alpha, float& l_reg, bf16x8& pa0, bf16x8& pa1, bf16x8& pa2, bf16x8& pa3) {
    _Pragma("unroll") for (int r = 0; r < 16; ++r) p1[r] = __builtin_amdgcn_exp2f(p1[r]);
    float ps = 0;
    _Pragma("unroll") for (int r = 0; r < 16; ++r) ps += p0[r];
    _Pragma("unroll") for (int r = 0; r < 16; ++r) ps += p1[r];
    { auto rr = __builtin_amdgcn_permlane32_swap(__float_as_uint(ps), __float_as_uint(ps), false, false);
      ps = __uint_as_float(rr[0]) + __uint_as_float(rr[1]); }
    l_reg = l_reg * alpha + ps;
#define PK4(P, B_, OUT) do { unsigned a0 = cvtpk(P[B_+0], P[B_+1]), a1 = cvtpk(P[B_+2], P[B_+3]);                          \
        unsigned b0 = cvtpk(P[B_+4], P[B_+5]), b1 = cvtpk(P[B_+6], P[B_+7]);                                             \
        auto r0 = __builtin_amdgcn_permlane32_swap(a0, b0, false, false); auto r1 = __builtin_amdgcn_permlane32_swap(a1, b1, false, false); \
        u32x4 w = {r0[0], r1[0], r0[1], r1[1]}; OUT = *reinterpret_cast<bf16x8*>(&w); } while (0)
    PK4(p0, 0, pa0); PK4(p0, 8, pa1); PK4(p1, 0, pa2); PK4(p1, 8, pa3);
#undef PK4
}
template <int KB>
__device__ __forceinline__ void qkt(f32x16& p0, f32x16& p1, const char* K_lds, int r32, int hi, const bf16x8* qr, float b0, const float (&ksm)[5]) {
    { const float bc0 = b0, bc1 = bc0 + ksm[0], bc2 = bc1 + ksm[0], bc3 = bc2 + ksm[0];
      p0[0] = bc0; p0[1] = bc1; p0[2] = bc2; p0[3] = bc3;
#pragma unroll
      for (int g = 1; g < 4; ++g) { p0[4 * g + 0] = bc0 + ksm[g]; p0[4 * g + 1] = bc1 + ksm[g]; p0[4 * g + 2] = bc2 + ksm[g]; p0[4 * g + 3] = bc3 + ksm[g]; }
#pragma unroll
      for (int r = 0; r < 16; ++r) p1[r] = p0[r] + ksm[4]; }
    const char* kb[4];
#pragma unroll
    for (int dd = 0; dd < 4; ++dd) kb[dd] = K_lds + KB * SHM_K + KSWZ(r32, (dd * 16 + hi * 8) * 2);
#pragma unroll
    for (int d0 = 0; d0 < 8; ++d0) { const char* a = kb[d0 & 3] + (d0 >> 2) * 128;
        bf16x8 b0v = *reinterpret_cast<const bf16x8*>(a);
        bf16x8 b1v = *reinterpret_cast<const bf16x8*>(a + 32 * 256);
        p0 = __builtin_amdgcn_mfma_f32_32x32x16_bf16(b0v, qr[d0], p0, 0, 0, 0);
        p1 = __builtin_amdgcn_mfma_f32_32x32x16_bf16(b1v, qr[d0], p1, 0, 0, 0); }
}
template <int VB>
__device__ __forceinline__ void pv_tile(f32x16* o, int vb0, bf16x8 pa0, bf16x8 pa1, bf16x8 pa2, bf16x8 pa3) {
#define TRRD(dst, off) asm volatile("ds_read_b64_tr_b16 %0, %1 offset:%2" : "=&v"(dst) : "v"(vb0), "i"(off) : "memory")
#define PV_D0(d0) do { s16x4 l0, l1, l2, l3, h0, h1, h2, h3; constexpr int b_ = VB * SHM_V + v_rd_off(d0, 0, 0);     \
        TRRD(l0, b_); TRRD(h0, b_ + 2048); TRRD(l1, b_ + 4096); TRRD(h1, b_ + 6144); TRRD(l2, b_ + 8192); TRRD(h2, b_ + 10240); TRRD(l3, b_ + 12288); TRRD(h3, b_ + 14336); \
        asm volatile("s_waitcnt lgkmcnt(0)" ::: "memory"); SBAR();                 \
        o[d0] = __builtin_amdgcn_mfma_f32_32x32x16_bf16(pa0, (bf16x8){l0[0], l0[1], l0[2], l0[3], h0[0], h0[1], h0[2], h0[3]}, o[d0], 0, 0, 0);   \
        o[d0] = __builtin_amdgcn_mfma_f32_32x32x16_bf16(pa1, (bf16x8){l1[0], l1[1], l1[2], l1[3], h1[0], h1[1], h1[2], h1[3]}, o[d0], 0, 0, 0);   \
        o[d0] = __builtin_amdgcn_mfma_f32_32x32x16_bf16(pa2, (bf16x8){l2[0], l2[1], l2[2], l2[3], h2[0], h2[1], h2[2], h2[3]}, o[d0], 0, 0, 0);   \
        o[d0] = __builtin_amdgcn_mfma_f32_32x32x16_bf16(pa3, (bf16x8){l3[0], l3[1], l3[2], l3[3], h3[0], h3[1], h3[2], h3[3]}, o[d0], 0, 0, 0); } while (0)
    PV_D0(0); PV_D0(1); PV_D0(2); PV_D0(3);
#undef PV_D0
#undef TRRD
}

struct BlockRef { const bf16* Q; const bf16* K; const bf16* V; bf16* O; const float* KM; int qb; float ks; };
struct Seam { bf16x8 qr[8]; bf16x8 st_v0, st_v1, st_k0, st_k1; };
#define ROW(p, k0, rr) ((p) + (size_t)((k0) + (rr)) * RS + sc)
#define VMW() asm volatile("s_waitcnt vmcnt(0)" ::: "memory")
#define VMWN(n) asm volatile("s_waitcnt vmcnt(%0)" :: "i"(n) : "memory")
#define SLOAD_H(Kp, Vp, k0) do { S.st_v0 = load8(ROW(Vp, k0, sr)); S.st_v1 = load8(ROW(Vp, k0, 32 + sr));              \
                         S.st_k0 = load8(ROW(Kp, k0, sr)); S.st_k1 = load8(ROW(Kp, k0, 32 + sr)); } while (0)
#define SWRITE_HK(bf) do { *(bf16x8*)(K_lds + (bf) * SHM_K + kws) = S.st_k0; *(bf16x8*)(K_lds + (bf) * SHM_K + kws + 32 * 256) = S.st_k1; } while (0)
#define SWRITE_HV(bf) do { *(bf16x8*)(V_lds + (bf) * SHM_V + vst0) = S.st_v0; *(bf16x8*)(V_lds + (bf) * SHM_V + vst1) = S.st_v1; } while (0)
#define SWRITE_H(bf) do { SWRITE_HV(bf); SWRITE_HK(bf); } while (0)
__device__ __forceinline__ void moba_prime(const BlockRef& cur, char* lds, Seam& S) {
    int tid_ = threadIdx.x; asm volatile("" : "+v"(tid_));
    const int tid = tid_, wid = __builtin_amdgcn_readfirstlane(tid >> 6), lane = tid & 63, r32 = lane & 31, hi = lane >> 5;
    const int sr = tid >> 4, sc = (tid & 15) * 8, kws = KSWZ(sr, sc * 2); char* K_lds = lds + 2 * SHM_V;
    _Pragma("unroll") for (int d0 = 0; d0 < 8; ++d0) S.qr[d0] = load8(cur.Q + (size_t)(wid * QBLK + r32) * RS + d0 * 16 + hi * 8);
    SLOAD_H(cur.K, cur.V, 0); VMW(); SWRITE_HK(0);
    __syncthreads();
}
__device__ __forceinline__ void moba_block(const BlockRef& cur, const BlockRef& nxt, char* lds, Seam& S) {
    int tid_ = threadIdx.x; asm volatile("" : "+v"(tid_));
    const int tid = tid_, wid = __builtin_amdgcn_readfirstlane(tid >> 6), lane = tid & 63, r32 = lane & 31, hi = lane >> 5;
    const int qb = cur.qb, P0 = qb * QB;
    const int NT = 4 * (qb + 1);
    const int qlo = P0 + wid * QBLK, qm = qlo + r32 - 4 * hi;
    char* V_lds = lds; char* K_lds = lds + 2 * SHM_V;
    float* ws = (float*)(lds + 2 * SHM_V + 2 * SHM_K) + wid * 64; float* li_l = ws, * al_l = ws + 32;
    float* KM = (float*)(lds + KM_OFF);
    if (tid < 256) *(f32x4*)(KM + tid * 4) = *(const f32x4*)(cur.KM + (size_t)(tid >> 5) * 1024 + (tid & 31) * 4);
    __syncthreads();
    unsigned selmask;
    {
        float g[7];
#pragma unroll
        for (int n = 0; n < 7; ++n) g[n] = 0.f;
#pragma unroll
        for (int d0 = 0; d0 < 8; ++d0) {
            float qf[8];
#pragma unroll
            for (int j = 0; j < 8; ++j) qf[j] = __uint_as_float(((unsigned)(unsigned short)S.qr[d0][j]) << 16);
#pragma unroll
            for (int n = 0; n < 7; ++n) if (n < qb) {
                const f32x4 k0 = *(const f32x4*)(KM + n * 128 + d0 * 16 + hi * 8), k1 = *(const f32x4*)(KM + n * 128 + d0 * 16 + hi * 8 + 4);
                g[n] += (qf[0] * k0[0] + qf[1] * k0[1]) + (qf[2] * k0[2] + qf[3] * k0[3]) + (qf[4] * k1[0] + qf[5] * k1[1]) + (qf[6] * k1[2] + qf[7] * k1[3]);
            }
        }
#pragma unroll
        for (int n = 0; n < 7; ++n) g[n] += __shfl_xor(g[n], 32);
        if (qb <= 3) selmask = (1u << qb) - 1u;
        else {
            selmask = 0u;
#pragma unroll
            for (int k = 0; k < 3; ++k) {
                int best = 0; float bv = -__builtin_inff();
#pragma unroll
                for (int n = 0; n < 7; ++n) if (n < qb && !((selmask >> n) & 1u) && g[n] > bv) { bv = g[n]; best = n; }
                selmask |= 1u << best;
            }
        }
        selmask |= 1u << qb;
    }
    const float NEGINF = -__builtin_inff();
    float ksm[5];
    { const float k1 = cur.ks, k2 = k1 + k1, k4 = k2 + k2, k8 = k4 + k4, k16 = k8 + k8, k24 = k16 + k8, k32 = k16 + k16;
      ksm[0] = __uint_as_float(__builtin_amdgcn_readfirstlane(__float_as_uint(k1))); ksm[1] = __uint_as_float(__builtin_amdgcn_readfirstlane(__float_as_uint(k8)));
      ksm[2] = __uint_as_float(__builtin_amdgcn_readfirstlane(__float_as_uint(k16))); ksm[3] = __uint_as_float(__builtin_amdgcn_readfirstlane(__float_as_uint(k24)));
      ksm[4] = __uint_as_float(__builtin_amdgcn_readfirstlane(__float_as_uint(k32))); }
    const float ks = ksm[0];
    float m_reg = -1e30f, l_reg = 0; f32x16 o[4] = {};
    const int sr = tid >> 4, sc = (tid & 15) * 8, vst0 = v_st(sr, sc), vst1 = v_st(32 + sr, sc), kws = KSWZ(sr, sc * 2);
    const int vb0 = (int)(uintptr_t)V_lds + v_rd_base(lane);
    const bf16* Kh = cur.K; const bf16* Vh = cur.V;
#define RESC(a) do { if (__any((a) < 1.f)) { if (hi == 0) al_l[r32] = (a); asm volatile("s_waitcnt lgkmcnt(0)" ::: "memory");              \
                     _Pragma("unroll") for (int d_ = 0; d_ < 4; ++d_) _Pragma("unroll") for (int r = 0; r < 16; ++r) o[d_][r] *= al_l[crow(r, hi)]; } } while (0)
#define KBASE(t) ((t) * KVBLK)
#define B0(t) ((((selmask >> ((t) >> 2)) & 1u) != 0u) ? -ks * (float)(qm - KBASE(t)) : NEGINF)
#define MASKT(P0_, P1_, t) do { const int kb_ = KBASE(t); if (kb_ + KVBLK - 1 > qlo) mask_tile(P0_, P1_, qm - kb_); } while (0)
#define SEAM_K0() do { VMWN(8); SWRITE_HK(0); SBAR(); } while (0)
    f32x16 pA0, pA1, pB0, pB1; float mnA, mnB, alA, alB; bf16x8 pa0, pa1, pa2, pa3;
    SWRITE_HV(0); SBAR();
    SLOAD_H(Kh, Vh, KBASE(1));
    SBAR(); qkt<0>(pA0, pA1, K_lds, r32, hi, S.qr, B0(0), ksm);
    MASKT(pA0, pA1, 0); partialSM(pA0, pA1, m_reg, mnA, alA);
    VMW(); SWRITE_H(1);
    __syncthreads();
#define HALF_STEP(PX0, PX1, mnX, alX, PY0, PY1, alY, t, KB, VB, SB) do {                                                      \
        SBAR(); qkt<KB>(PX0, PX1, K_lds, r32, hi, S.qr, B0(t), ksm);                                                           \
        finishSM(PY0, PY1, alY, l_reg, pa0, pa1, pa2, pa3); SBAR();                                                           \
        if ((t) + 1 < NT) { SLOAD_H(Kh, Vh, KBASE((t) + 1)); SBAR(); }                                                        \
        pv_tile<VB>(o, vb0, pa0, pa1, pa2, pa3); MASKT(PX0, PX1, (t)); partialSM(PX0, PX1, m_reg, mnX, alX);                  \
        __syncthreads();                                                                                                      \
        if ((t) + 1 < NT) { VMW(); SWRITE_H(SB); }                                                                            \
        RESC(alX); __syncthreads(); } while (0)
    for (int t = 1; t + 1 < NT; t += 2) {
        HALF_STEP(pB0, pB1, mnB, alB, pA0, pA1, alA, t, 1, 0, 0);
        HALF_STEP(pA0, pA1, mnA, alA, pB0, pB1, alB, t + 1, 0, 1, 1);
    }
    SBAR(); qkt<1>(pB0, pB1, K_lds, r32, hi, S.qr, B0(NT - 1), ksm); SBAR();
    SLOAD_H(nxt.K, nxt.V, 0); SBAR();
#pragma unroll
    for (int d0 = 0; d0 < 8; ++d0) S.qr[d0] = load8(nxt.Q + (size_t)(wid * QBLK + r32) * RS + d0 * 16 + hi * 8);
    SBAR();
    finishSM(pA0, pA1, alA, l_reg, pa0, pa1, pa2, pa3); SBAR();
    pv_tile<0>(o, vb0, pa0, pa1, pa2, pa3);
    MASKT(pB0, pB1, NT - 1); partialSM(pB0, pB1, m_reg, mnB, alB); __syncthreads(); RESC(alB);
    finishSM(pB0, pB1, alB, l_reg, pa0, pa1, pa2, pa3); SBAR(); pv_tile<1>(o, vb0, pa0, pa1, pa2, pa3);
    SBAR(); SEAM_K0();
    if (hi == 0) li_l[r32] = l_reg; asm volatile("s_waitcnt lgkmcnt(0)" ::: "memory");
    float rli[16];
#pragma unroll
    for (int r = 0; r < 16; ++r) rli[r] = __builtin_amdgcn_rcpf(li_l[crow(r, hi)]);
    bf16* Ow = cur.O + (size_t)(wid * QBLK) * RS;
#pragma unroll
    for (int r = 0; r < 16; ++r) { const int orow = crow(r, hi);
#pragma unroll
        for (int d0 = 0; d0 < 4; ++d0) { const float v = o[d0][r] * rli[r];
            const float vn = __shfl_xor(v, 1);
            if ((r32 & 1) == 0) *(unsigned*)(Ow + (size_t)orow * RS + d0 * 32 + r32) = cvtpk(v, vn); } }
    __syncthreads();
#undef RESC
#undef KBASE
#undef B0
#undef MASKT
#undef SEAM_K0
#undef HALF_STEP
}
#undef ROW
#undef VMW
#undef VMWN
#undef SLOAD_H
#undef SWRITE_HK
#undef SWRITE_HV
#undef SWRITE_H
#undef KSWZ
#undef SBAR
}
#define GAS __attribute__((address_space(1)))
#define LAS __attribute__((address_space(3)))
typedef unsigned short bf16;
typedef unsigned v4u __attribute__((ext_vector_type(4)));
typedef float f32x4 __attribute__((ext_vector_type(4)));
typedef short bf16x8 __attribute__((ext_vector_type(8)));
typedef GAS unsigned gu32;
typedef GAS unsigned long long gu64;
#define RLX_AGENT __ATOMIC_RELAXED, __HIP_MEMORY_SCOPE_AGENT
#define LDS_WAIT() asm volatile("s_waitcnt lgkmcnt(0)" ::: "memory")
#define VM_WAIT() asm volatile("s_waitcnt vmcnt(0)" ::: "memory")
__device__ __forceinline__ unsigned long long rt() { return __builtin_amdgcn_s_memrealtime(); }
__device__ __forceinline__ unsigned f2bf(float f) { unsigned u = __builtin_bit_cast(unsigned, f); return (u + 0x7fffu + ((u >> 16) & 1u)) >> 16; }
__device__ __forceinline__ unsigned pk2(float lo, float hi) { return f2bf(lo) | (f2bf(hi) << 16); }

#define XB_TMO      128
#define XB_XCNT(j)  (256  + 64 * (j))
#define XB_XSUB(j)  (1280 + 64 * (j))
#define XB_XGEN(j)  (2304 + 64 * (j))
#define XB_TOP      3328
#define XB_TOPGEN   3392
#define XCD_BAR_WORDS 3456
#define XB_SPIN_CAP (1u << 18)

__device__ __forceinline__ unsigned xb_ld(unsigned* p)              { return __hip_atomic_load(p, __ATOMIC_RELAXED, __HIP_MEMORY_SCOPE_AGENT); }
__device__ __forceinline__ unsigned xb_add(unsigned* p, unsigned v) { return __hip_atomic_fetch_add(p, v, __ATOMIC_RELAXED, __HIP_MEMORY_SCOPE_AGENT); }
__device__ __forceinline__ unsigned xb_xcc_id() { return (unsigned)__builtin_amdgcn_s_getreg((3 << 11) | 20) & 0xFu; }
#define XB_SPIN(cond, bar) do { unsigned _sp = 0; while (cond) { __builtin_amdgcn_s_sleep(1); \
    if ((++_sp & 255u) == 0u) { if (xb_ld(&(bar)[XB_TMO])) break; if (_sp > XB_SPIN_CAP) { atomicAdd(&(bar)[XB_TMO], 1u); break; } } } } while (0)

struct XcdBarrier {
    unsigned* bar; unsigned x;
    volatile LAS unsigned* st;
};

__device__ __forceinline__ XcdBarrier xcd_barrier_post(unsigned* bar, volatile LAS unsigned* st) {
    XcdBarrier b; b.bar = bar; b.x = xb_xcc_id(); b.st = st;
    if (threadIdx.x == 0) (void)xb_add(&bar[XB_XCNT(b.x)], 1u);
    return b;
}
__device__ __forceinline__ void xcd_barrier_complete(unsigned* bar, unsigned x, unsigned& nloc, unsigned& nx) {
    const unsigned G = gridDim.x * gridDim.y * gridDim.z;
    unsigned sum, cnt, mine, sp = 0u;
    for (;;) {
        sum = 0u; cnt = 0u; mine = 0u;
#pragma nounroll
        for (unsigned j = 0; j < 16; ++j) { const unsigned c = xb_ld(&bar[XB_XCNT(j)]); sum += c; cnt += (c > 0u) ? 1u : 0u; mine = (j == x) ? c : mine; }
        if (sum == G) break;
        __builtin_amdgcn_s_sleep(1);
        if ((++sp & 255u) == 0u) { if (xb_ld(&bar[XB_TMO])) break; if (sp > XB_SPIN_CAP) { atomicAdd(&bar[XB_TMO], 1u); break; } }
    }
    nloc = mine > 0u ? mine : 1u; nx = cnt > 0u ? cnt : 1u;
}

__device__ __forceinline__ void xcd_barrier(const XcdBarrier& b) {
    asm volatile("s_waitcnt vmcnt(0)" ::: "memory");
    __syncthreads();
    if (threadIdx.x == 0) {
        unsigned* bar = b.bar; asm volatile("" : "+s"(bar));
        __builtin_amdgcn_s_waitcnt(0);
        unsigned nloc = b.st[0], nx = b.st[1];
        if (nloc == 0u) { xcd_barrier_complete(bar, b.x, nloc, nx); b.st[0] = nloc; b.st[1] = nx; }
        const unsigned old = xb_add(&bar[XB_XSUB(b.x)], 1u);
        const unsigned gen = old / nloc;
        if (old + 1u == (gen + 1u) * nloc) {
            __builtin_amdgcn_fence(__ATOMIC_RELEASE, "agent");
            asm volatile("s_waitcnt vmcnt(0)" ::: "memory");
            const unsigned og = xb_add(&bar[XB_TOP], 1u);
            const unsigned tg = og / nx;
            if (og + 1u == (tg + 1u) * nx) xb_add(&bar[XB_TOPGEN], 1u);
            else XB_SPIN(xb_ld(&bar[XB_TOPGEN]) == tg, bar);
            __builtin_amdgcn_fence(__ATOMIC_ACQUIRE, "agent");
            xb_add(&bar[XB_XGEN(b.x)], 1u);
            asm volatile("s_waitcnt vmcnt(0)" ::: "memory");
        } else {
            XB_SPIN(xb_ld(&bar[XB_XGEN(b.x)]) == gen, bar);
            __builtin_amdgcn_fence(__ATOMIC_ACQUIRE, "agent");
            asm volatile("s_waitcnt vmcnt(0)" ::: "memory");
        }
    }
    __syncthreads();
}
typedef float f32x2v __attribute__((ext_vector_type(2)));
constexpr int NWAVES = 8;
constexpr int BATCH = 8, SEQ = 2048, DM = 1024, NH = 8, FF = 2816, DEPTH = 4;
constexpr int M = BATCH * SEQ;
constexpr size_t MiB = 1u << 20;
constexpr size_t WS_CTL = 0;
constexpr size_t WS_KSUM = 1 * MiB;
constexpr size_t ZERO_BYTES = 2 * MiB;
constexpr size_t WS_VEC = 2 * MiB;
constexpr size_t WS_STATS = 4 * MiB;
constexpr int V_QKV = 0, V_LIN = 2 * 3072, V_FIN = V_LIN + 2 * 2048, V_TOTAL = V_FIN + 4 * 5632;
constexpr size_t WS_W = 8 * MiB;
constexpr size_t W_QKV = 0, W_WO = W_QKV + 2ull * 3072 * 1024, W_LIN = W_WO + 2ull * 1024 * 1024, W_LOUT = W_LIN + 2ull * 2048 * 1024,
                 W_FIN = W_LOUT + 2ull * 1024 * 1024, W_FOUT = W_FIN + 4ull * 5632 * 1024, W_GA = W_FOUT + 4ull * 1024 * 2816, W_GX = W_GA + 2ull * 8 * 128 * 128,
                 W_END = W_GX + 2ull * 8 * 128 * 128;
constexpr size_t WS_XB16 = 104 * MiB;
constexpr size_t WS_T = 136 * MiB;
constexpr size_t WS_VECP = 264 * MiB;
constexpr size_t WS_LO16 = 266 * MiB;
constexpr size_t WS_END = 298 * MiB;
static_assert(WS_W + W_END * 2 <= WS_XB16, "weights fit");
constexpr int CW_BAR = 1024;

constexpr int RING_OFF = 0, RING_BYTES = 131072;
constexpr int LDSCTL_OFF = RING_BYTES, MISC_OFF = LDSCTL_OFF + 320, SPARE_OFF = RING_BYTES + 1024;
constexpr int LDS_BYTES = 147456;

__device__ __forceinline__ float bf2f(unsigned short b) { return __uint_as_float(((unsigned)b) << 16); }
__device__ __forceinline__ float wave_sum(float v) {
#pragma unroll
    for (int o = 1; o < 64; o <<= 1) v += __shfl_xor(v, o);
    return v;
}

__device__ __forceinline__ int dest_col(int n, int perm) { if (!perm) return n; const int j = n < FF ? n : n - FF; return 256 * (j >> 7) + (n < FF ? 0 : 128) + (j & 127); }
__device__ __forceinline__ void p0_task(const float* W, int K, int N, bf16* WT, const float* gain, const float* lbias, float* cvec, float* bvec, int perm, int task, int lane, int dry) {
    const int nblk = N / 64, kb = task / nblk, nb = task % nblk, k0 = 128 * kb, n = 64 * nb + lane, d = dest_col(n, perm);
    const GAS float* src = (const GAS float*)W + (size_t)k0 * N + n;
    GAS v4u* dst = (GAS v4u*)(WT + (size_t)d * K + k0);
    float cs = 0.f, bs = 0.f;
#pragma unroll
    for (int q2 = 0; q2 < 2; ++q2) {
        float w[64];
#pragma unroll
        for (int i = 0; i < 64; ++i) w[i] = src[(size_t)(q2 * 64 + i) * N];
        if (gain) {
#pragma unroll
            for (int i = 0; i < 64; ++i) { const int k = k0 + q2 * 64 + i; if (cvec) bs = fmaf(lbias[k], w[i], bs); w[i] *= gain[k]; }
        }
#pragma unroll
        for (int c = 0; c < 8; ++c) { v4u o; o.x = pk2(w[8 * c + 0], w[8 * c + 1]); o.y = pk2(w[8 * c + 2], w[8 * c + 3]); o.z = pk2(w[8 * c + 4], w[8 * c + 5]); o.w = pk2(w[8 * c + 6], w[8 * c + 7]);
            if (cvec) { const unsigned ow[4] = {o.x, o.y, o.z, o.w};
#pragma unroll
                for (int e = 0; e < 4; ++e) cs += __uint_as_float(ow[e] << 16) + __uint_as_float(ow[e] & 0xffff0000u); }
            dst[q2 * 8 + c] = o; }
    }
    if (cvec && !dry) { cvec[(size_t)kb * V_TOTAL + d] = cs; bvec[(size_t)kb * V_TOTAL + d] = bs; }
}

struct Args { const float* in[16]; float* out; unsigned char* ws; int ph_lo, ph_hi; };

namespace lru {
constexpr int L_WA = 0, L_WX = 8192, L_XB = 16384, L_XC = L_XB + 33792, L_CMP = L_XC + 32768, L_GT = L_CMP + 2048, L_CW = L_GT + 8192, L_END = L_CW + 2560;
static_assert(L_END <= RING_BYTES, "lru lds");
__device__ __forceinline__ void phase(LAS unsigned char* lds, int vcu, const bf16* xb, const bf16* gate, bf16* hg, const bf16* wta, const bf16* wtx,
                                      const float* conv_w, const float* conv_b, const float* b_a, const float* b_x, const float* lam) {
    typedef float f32x4 __attribute__((ext_vector_type(4)));
    int tid_ = threadIdx.x; asm volatile("" : "+v"(tid_));
    const int tid = tid_, w = __builtin_amdgcn_readfirstlane(tid >> 6), lane = tid & 63, l15 = lane & 15, q = lane >> 4;
    const int b = vcu >> 5, g = (vcu >> 2) & 7, qd = vcu & 3, ch0 = g * 128 + qd * 32;
    { const int n = tid >> 4, ck = tid & 15;
      const v4u va = *(const GAS v4u*)(wta + ((size_t)(g * 128 + qd * 32 + n)) * 128 + ck * 8), vx = *(const GAS v4u*)(wtx + ((size_t)(g * 128 + qd * 32 + n)) * 128 + ck * 8);
      *(LAS v4u*)(lds + L_WA + n * 256 + ((ck ^ (n & 15)) * 16)) = va; *(LAS v4u*)(lds + L_WX + n * 256 + ((ck ^ (n & 15)) * 16)) = vx;
      if (tid < 128) { LAS float* cw = (LAS float*)(lds + L_CW);
#pragma unroll
          for (int tap = 0; tap < 4; ++tap) cw[tap * 128 + tid] = conv_w[tap * 1024 + g * 128 + tid];
          cw[4 * 128 + tid] = conv_b[g * 128 + tid]; } }
    float ba[2], bx[2], la2[2], carry[2];
#pragma unroll
    for (int nt = 0; nt < 2; ++nt) { const int ch = ch0 + nt * 16 + l15; ba[nt] = b_a[ch]; bx[nt] = b_x[ch];
        const float nl = -lam[ch]; const float sp = fmaxf(nl, 0.f) + log1pf(expf(-fabsf(nl)));
        la2[nt] = -8.0f * sp * 1.4426950408889634f; carry[nt] = 0.f; }
    __syncthreads();
    const size_t rowbase = (size_t)b * SEQ;
    v4u sx[5], sg;
#define LRU_ISSUE(cn) do { const int t0n = (cn) * 128;                                                                                   \
        _Pragma("unroll") for (int k = 0; k < 5; ++k) { const int i = tid + 512 * k; const int r = i >> 4, ck = i & 15, tok = t0n - 3 + r;  \
            sx[k] = (v4u){0u, 0u, 0u, 0u};                                                                                                 \
            if (i < 131 * 16 && tok >= 0) sx[k] = *(const GAS v4u*)(xb + (rowbase + tok) * 1024 + g * 128 + ck * 8); }                      \
        sg = *(const GAS v4u*)(gate + (rowbase + t0n + (tid >> 2)) * 1024 + ch0 + (tid & 3) * 8); } while (0)
    LRU_ISSUE(0);
    for (int c = 0; c < SEQ / 128; ++c) {
        const int t0 = c * 128;
#pragma unroll
        for (int k = 0; k < 5; ++k) { const int i = tid + 512 * k; if (i < 131 * 16) *(LAS v4u*)(lds + L_XB + (i >> 4) * 256 + (i & 15) * 16) = sx[k]; }
        *(LAS v4u*)(lds + L_GT + (tid >> 2) * 64 + (tid & 3) * 16) = sg;
        __syncthreads();
        if (c + 1 < SEQ / 128) LRU_ISSUE(c + 1);
        { const int ck = tid & 15; const LAS float* cw = (const LAS float*)(lds + L_CW);
          float wt[4][8], cb[8];
#pragma unroll
          for (int j = 0; j < 8; ++j) { cb[j] = cw[4 * 128 + ck * 8 + j];
#pragma unroll
              for (int tap = 0; tap < 4; ++tap) wt[tap][j] = cw[tap * 128 + ck * 8 + j]; }
#pragma unroll
          for (int i = 0; i < 4; ++i) { const int tok = (tid >> 4) + 32 * i; float a[8];
#pragma unroll
              for (int j = 0; j < 8; ++j) a[j] = cb[j];
#pragma unroll
              for (int tap = 0; tap < 4; ++tap) { const v4u xv = *(const LAS v4u*)(lds + L_XB + (tok + tap) * 256 + ck * 16);
                  const unsigned xw[4] = {xv.x, xv.y, xv.z, xv.w};
#pragma unroll
                  for (int j = 0; j < 4; ++j) { a[2 * j] = fmaf(wt[tap][2 * j], __uint_as_float(xw[j] << 16), a[2 * j]); a[2 * j + 1] = fmaf(wt[tap][2 * j + 1], __uint_as_float(xw[j] & 0xffff0000u), a[2 * j + 1]); } }
              v4u o; o.x = pk2(a[0], a[1]); o.y = pk2(a[2], a[3]); o.z = pk2(a[4], a[5]); o.w = pk2(a[6], a[7]);
              *(LAS v4u*)(lds + L_XC + tok * 256 + ((ck ^ (tok & 15)) * 16)) = o; } }
        __syncthreads();
        f32x4 accR[2], accI[2];
#pragma unroll
        for (int nt = 0; nt < 2; ++nt) { accR[nt] = (f32x4){0.f, 0.f, 0.f, 0.f}; accI[nt] = (f32x4){0.f, 0.f, 0.f, 0.f}; }
#pragma unroll
        for (int s = 0; s < 4; ++s) { const int ck = 4 * s + q;
            const bf16x8 af = *(const LAS bf16x8*)(lds + L_XC + (16 * w + l15) * 256 + ((ck ^ l15) * 16));
#pragma unroll
            for (int nt = 0; nt < 2; ++nt) {
                const bf16x8 bfa = *(const LAS bf16x8*)(lds + L_WA + (nt * 16 + l15) * 256 + ((ck ^ l15) * 16));
                const bf16x8 bfx = *(const LAS bf16x8*)(lds + L_WX + (nt * 16 + l15) * 256 + ((ck ^ l15) * 16));
                accR[nt] = __builtin_amdgcn_mfma_f32_16x16x32_bf16(af, bfa, accR[nt], 0, 0, 0);
                accI[nt] = __builtin_amdgcn_mfma_f32_16x16x32_bf16(af, bfx, accI[nt], 0, 0, 0); } }
        float av[2][4], bv[2][4], Aex[2], Hex[2];
        LAS f32x2v* cmp = (LAS f32x2v*)(lds + L_CMP);
#pragma unroll
        for (int nt = 0; nt < 2; ++nt) { const int cl = qd * 32 + nt * 16 + l15; float A = 1.f, H = 0.f;
#pragma unroll
            for (int i = 0; i < 4; ++i) { const int tok = 16 * w + 4 * q + i;
                const float xcv = bf2f(*(const LAS unsigned short*)(lds + L_XC + tok * 256 + (((cl >> 3) ^ (tok & 15)) * 16) + (cl & 7) * 2));
                const float r = pg8::fast_sigmoid(accR[nt][i] + ba[nt]), ig = pg8::fast_sigmoid(accI[nt][i] + bx[nt]);
                const float a = __builtin_amdgcn_exp2f(la2[nt] * r); const float mult = __builtin_amdgcn_sqrtf(fmaxf(fmaf(-a, a, 1.0f), 0.f));
                av[nt][i] = a; bv[nt][i] = mult * (ig * xcv); H = fmaf(a, H, bv[nt][i]); A *= a; }
            { float Ap = __shfl_up(A, 16), Hp = __shfl_up(H, 16); if (q >= 1) { H = fmaf(A, Hp, H); A *= Ap; } }
            { float Ap = __shfl_up(A, 32), Hp = __shfl_up(H, 32); if (q >= 2) { H = fmaf(A, Hp, H); A *= Ap; } }
            { float Ap = __shfl_up(A, 16), Hp = __shfl_up(H, 16); Aex[nt] = q >= 1 ? Ap : 1.f; Hex[nt] = q >= 1 ? Hp : 0.f; }
            if (q == 3) cmp[w * 32 + nt * 16 + l15] = (f32x2v){A, H}; }
        __syncthreads();
#pragma unroll
        for (int nt = 0; nt < 2; ++nt) { float Ap = 1.f, Hp = 0.f, At = 1.f, Ht = 0.f;
#pragma unroll
            for (int v = 0; v < 8; ++v) { const f32x2v e = cmp[v * 32 + nt * 16 + l15]; Ht = fmaf(e.x, Ht, e.y); At *= e.x; if (v < w) { Hp = Ht; Ap = At; } }
            float h = fmaf(Ap, carry[nt], Hp);
            h = fmaf(Aex[nt], h, Hex[nt]);
#pragma unroll
            for (int i = 0; i < 4; ++i) { const int tok = 16 * w + 4 * q + i; h = fmaf(av[nt][i], h, bv[nt][i]);
                LAS unsigned short* gp = (LAS unsigned short*)(lds + L_GT + tok * 64 + (nt * 16 + l15) * 2);
                *gp = (unsigned short)f2bf(h * bf2f(*gp)); }
            carry[nt] = fmaf(At, carry[nt], Ht); }
        __syncthreads();
        { const int r = tid >> 2, ck = tid & 3; *(GAS v4u*)(hg + (rowbase + t0 + r) * 1024 + ch0 + ck * 8) = *(const LAS v4u*)(lds + L_GT + r * 64 + ck * 16); }
    }
    __syncthreads();
#undef LRU_ISSUE
}
}

__device__ __forceinline__ unsigned long long ld_tbl(LAS unsigned char* lds, int k) {
    const unsigned long long v = *(volatile LAS unsigned long long*)(lds + LDSCTL_OFF + 8 * k);
    return ((unsigned long long)(unsigned)__builtin_amdgcn_readfirstlane((int)(unsigned)(v >> 32)) << 32) | (unsigned long long)(unsigned)__builtin_amdgcn_readfirstlane((int)(unsigned)v);
}
#define INP(k) ((const float*)ld_tbl(lds, (k)))
#define OUTP() ((float*)ld_tbl(lds, 16))
#define WSP() ((unsigned char*)ld_tbl(lds, 17))
__device__ __forceinline__ void convert_set(LAS unsigned char* lds, unsigned char* ws, int set, int worker, int nworkers, int lane, int dry) {
    float* vec = (float*)(ws + WS_VECP); bf16* Wb = (bf16*)(ws + WS_W);
    const float* lng = INP(14); const float* lnb = INP(15);
    constexpr int I_QKV = (1024 / 128) * (3072 / 64), I_SQ = (1024 / 128) * (1024 / 64), I_LIN = (1024 / 128) * (2048 / 64), I_FIN = (1024 / 128) * (5632 / 64), I_FOUT = (2816 / 128) * (1024 / 64), I_GT = 32;
    const int j = set >> 1, odd = set & 1;
    const int n_mix_in = odd ? I_LIN : I_QKV, n_items = n_mix_in + I_SQ + (odd ? I_GT : 0) + I_FIN + I_FOUT;
    for (int it = worker; it < n_items; it += nworkers) {
        int r = it;
        const float* W; int K = 1024, N; bf16* WT; const float* gn = nullptr; const float* lbv = nullptr; float* cv = nullptr; float* bv = nullptr; int perm = 0;
        if (r < n_mix_in) {
            if (!odd) { W = INP(1) + (size_t)j * 1024 * 3072; N = 3072; WT = Wb + W_QKV + (size_t)j * 3072 * 1024;
                if (j) { gn = lng + 3 * 1024; lbv = lnb + 3 * 1024; cv = vec + V_QKV + 3072; bv = vec + 8 * V_TOTAL + V_QKV + 3072; } }
            else { const int li = (j == 0) ? 1 : 5;
                W = INP(3) + (size_t)j * 1024 * 2048; N = 2048; WT = Wb + W_LIN + (size_t)j * 2048 * 1024; gn = lng + li * 1024; lbv = lnb + li * 1024; cv = vec + V_LIN + j * 2048; bv = vec + 8 * V_TOTAL + V_LIN + j * 2048; } }
        else if ((r -= n_mix_in) < I_SQ) { W = INP(odd ? 11 : 2) + (size_t)j * 1024 * 1024; N = 1024; WT = Wb + (odd ? W_LOUT : W_WO) + (size_t)j * 1024 * 1024; }
        else if ((r -= I_SQ) < (odd ? I_GT : 0)) { const int mat = r >> 1, which = mat >> 3, g = mat & 7; r &= 1;
            W = INP(which ? 8 : 6) + (size_t)(j * 8 + g) * 16384; K = 128; N = 128; WT = Wb + (which ? W_GX : W_GA) + (size_t)(j * 8 + g) * 16384; }
        else if ((r -= (odd ? I_GT : 0)) < I_FIN) { const int li = 2 * set;
            W = INP(12) + (size_t)set * 1024 * 5632; N = 5632; WT = Wb + W_FIN + (size_t)set * 5632 * 1024; gn = lng + li * 1024; lbv = lnb + li * 1024; cv = vec + V_FIN + set * 5632; bv = vec + 8 * V_TOTAL + V_FIN + set * 5632; perm = 1; }
        else { r -= I_FIN; W = INP(13) + (size_t)set * 2816 * 1024; K = 2816; N = 1024; WT = Wb + W_FOUT + (size_t)set * 1024 * 2816; }
        p0_task(W, K, N, WT, gn, lbv, cv, bv, perm, r, lane, dry);
    }
}
__device__ __forceinline__ void finalize_vec(unsigned char* ws, int bx, int G) {
    const float* vp = (const float*)(ws + WS_VECP); float* vf = (float*)(ws + WS_VEC);
    int tf_ = threadIdx.x; asm volatile("" : "+v"(tf_));
    for (int col = bx * (NWAVES * 64) + tf_; col < V_TOTAL; col += G * NWAVES * 64) { float c = 0.f, bsum = 0.f;
        if (col >= 3072) {
#pragma unroll
            for (int kb = 0; kb < 8; ++kb) { c += vp[(size_t)kb * V_TOTAL + col]; bsum += vp[(size_t)(8 + kb) * V_TOTAL + col]; } }
        vf[col] = c; vf[V_TOTAL + col] = bsum; }
}
#ifndef REPMASK
#define REPMASK 0
#endif
#define REP_A1 ((REPMASK >> 0) & 1 ? 0 : 1)
#define REP_A2 ((REPMASK >> 1) & 1 ? 0 : 1)
#define REP_OUT ((REPMASK >> 2) & 1 ? 0 : 1)
#define REP_F1 ((REPMASK >> 3) & 1 ? 0 : 1)
#define REP_R1 ((REPMASK >> 4) & 1 ? 0 : 1)
#define REP_R2 ((REPMASK >> 5) & 1 ? 0 : 1)
#define REP_P0 ((REPMASK >> 6) & 1 ? 0 : 1)
#define REP_FIN ((REPMASK >> 7) & 1 ? 0 : 1)
#define REP_BAR ((REPMASK >> 8) & 1)
constexpr int NPHASES = 22;
__global__ void __launch_bounds__(NWAVES * 64, 2) mega_fwd(Args args) {
    extern __shared__ __attribute__((aligned(16))) unsigned char lds_raw[];
    LAS unsigned char* lds = (LAS unsigned char*)lds_raw;
    for (int u = threadIdx.x; u < (LDS_BYTES - LDSCTL_OFF) / 4; u += NWAVES * 64) ((LAS unsigned*)(lds + LDSCTL_OFF))[u] = 0u;
    __syncthreads();
    if (threadIdx.x < 18) { const unsigned long long v = threadIdx.x < 16 ? (unsigned long long)args.in[threadIdx.x] : (threadIdx.x == 16 ? (unsigned long long)args.out : (unsigned long long)args.ws);
        *(LAS unsigned long long*)(lds + LDSCTL_OFF + 8 * threadIdx.x) = v; }
    __syncthreads();
    XcdBarrier bar = xcd_barrier_post((unsigned*)(WSP() + WS_CTL) + CW_BAR, (volatile LAS unsigned*)(lds + MISC_OFF) + 8);
    const int lo = args.ph_lo, hi = args.ph_hi;
    if (hi < 0) cooperative_groups::this_grid().sync();
    int ph = 0;
#define PH_BEGIN if (ph >= lo && ph < hi) { const int G = gridDim.x, bx = blockIdx.x, vcu = (G % 8 == 0) ? (bx % 8) * (G / 8) + bx / 8 : bx; (void)vcu; unsigned char* ws = WSP(); (void)ws;
#define PH_END   if (ph + 1 < hi) { xcd_barrier(bar); if (REP_BAR) xcd_barrier(bar); } } ++ph;

    PH_BEGIN
    {
        const int lane = threadIdx.x & 63, wave = __builtin_amdgcn_readfirstlane(threadIdx.x >> 6);
        const int gw = vcu * NWAVES + wave, NGW = G * NWAVES;
        _Pragma("nounroll") for (int rep_ = REP_P0; rep_ < 2; ++rep_) {
        const int dry = (rep_ == 0);
        convert_set(lds, ws, 0, gw, NGW, lane, dry);
        const float* x = INP(0); bf16* XB16 = (bf16*)(ws + WS_XB16);
        for (int m0 = gw; m0 < M; m0 += 4 * NGW) {
            f32x4 xv[4][4];
#pragma unroll
            for (int rr = 0; rr < 4; ++rr) { const int m = m0 + rr * NGW; const GAS f32x4* xr = (const GAS f32x4*)(x + (size_t)(m < M ? m : m0) * DM) + lane;
#pragma unroll
                for (int j = 0; j < 4; ++j) xv[rr][j] = xr[64 * j]; }
#pragma unroll
            for (int rr = 0; rr < 4; ++rr) { const int m = m0 + rr * NGW; if (m < M) {
                GAS unsigned long long* o8 = (GAS unsigned long long*)(XB16 + (size_t)m * DM) + lane; GAS unsigned long long* l8 = (GAS unsigned long long*)((bf16*)(ws + WS_LO16) + (size_t)m * DM) + lane;
#pragma unroll
                for (int j = 0; j < 4; ++j) { const f32x4 v = xv[rr][j]; const unsigned h0 = pk2(v.x, v.y), h1 = pk2(v.z, v.w);
                    o8[64 * j] = (unsigned long long)h0 | ((unsigned long long)h1 << 32);
                    l8[64 * j] = (unsigned long long)pk2(v.x - __uint_as_float(h0 << 16), v.y - __uint_as_float(h0 & 0xffff0000u)) | ((unsigned long long)pk2(v.z - __uint_as_float(h1 << 16), v.w - __uint_as_float(h1 & 0xffff0000u)) << 32); } } }
        }
        }
    }
    PH_END

#pragma nounroll
    for (int layer_ = 0; layer_ < DEPTH; ++layer_) {
#define LAYER_VARS int layer = layer_; asm volatile("" : "+s"(layer)); const int j = layer >> 1; (void)j; \
        float* stats = (float*)(ws + WS_STATS); bf16* Wb = (bf16*)(ws + WS_W); bf16* XB16 = (bf16*)(ws + WS_XB16); unsigned char* T = ws + WS_T; (void)Wb; (void)XB16; (void)T; \
        const float* st_mix_in = layer ? stats + (size_t)(2 * layer - 1) * M * 8 : nullptr; float* st_mix_out = stats + (size_t)(2 * layer) * M * 8; float* st_ffn_out = stats + (size_t)(2 * layer + 1) * M * 8; \
        (void)st_mix_in; (void)st_mix_out; (void)st_ffn_out;
        if ((layer_ & 1) == 0) {
            PH_BEGIN
            {
                LAYER_VARS
                float* vec = (float*)(ws + WS_VEC); float* ks_l = (float*)(ws + WS_KSUM) + (size_t)j * 64 * 1024;
                pg8::Gemm g{XB16, Wb + W_QKV + (size_t)j * 3072 * 1024, M, 3072, 1024}; pg8::StaticOrder S; S.init(M, 3072, G, bx);
                pg8::EpiIn<0> E{st_mix_in, vec + V_QKV + j * 3072, vec + V_TOTAL + V_QKV + j * 3072, (bf16*)T, ks_l, 0};
#ifndef NO_G0
                _Pragma("nounroll") for (int rep_ = REP_A1; rep_ < 2; ++rep_) { E.dry = (rep_ == 0); pg8::gemm_phase<pg8::EpiIn<0>, pg8::StaticOrder, true, true>(lds + RING_OFF, g, S, E); }
#endif
            }
            PH_END
            PH_BEGIN
            {
                LAYER_VARS
                if (layer == 0) finalize_vec(ws, bx, G);
#ifndef NO_ATTN
                _Pragma("nounroll") for (int rep_ = REP_A2; rep_ < 2; ++rep_)
                if (vcu < 256) {
                    bf16* Qb = (bf16*)T; bf16* Kb = (bf16*)(T + 32 * MiB); bf16* Vb = (bf16*)(T + 64 * MiB); bf16* Ob = (bf16*)(T + 96 * MiB);
                    const float* ks_l = (const float*)(ws + WS_KSUM) + (size_t)j * 64 * 1024;
                    const int bh = vcu >> 2, xq = vcu & 3, b = bh >> 3, h = bh & 7;
                    const float ksl = exp2f(-(float)(h + 1)) / moba::SCALE;
                    const size_t hb = (size_t)b * SEQ * 1024 + (size_t)h * 128;
                    moba::BlockRef cur{Qb + hb + (size_t)xq * 256 * 1024, Kb + hb, Vb + hb, Ob + hb + (size_t)xq * 256 * 1024, ks_l + (size_t)b * 8 * 1024 + h * 128, xq, ksl};
                    moba::Seam S;
                    moba::moba_prime(cur, (char*)lds_raw + RING_OFF, S);
#pragma nounroll
                    for (int pass = 0; pass < 2; ++pass) {
                        moba::BlockRef nxt = cur; nxt.qb = 7 - xq; nxt.Q = Qb + hb + (size_t)(7 - xq) * 256 * 1024; nxt.O = Ob + hb + (size_t)(7 - xq) * 256 * 1024;
                        moba::moba_block(cur, nxt, (char*)lds_raw + RING_OFF, S); cur = nxt; }
                }
#endif
            }
            PH_END
            PH_BEGIN
            {
                LAYER_VARS
                const float* lng = INP(14); const float* lnb = INP(15);
                pg8::Gemm g{(bf16*)(T + 96 * MiB), Wb + W_WO + (size_t)j * 1024 * 1024, M, 1024, 1024}; pg8::StaticOrder S; S.init(M, 1024, G, bx);
                pg8::EpiOut E{st_mix_in, layer ? lng + (size_t)(2 * layer - 1) * 1024 : nullptr, layer ? lnb + (size_t)(2 * layer - 1) * 1024 : nullptr, XB16, (bf16*)(ws + WS_LO16), st_mix_out, 0, (LAS float*)(lds + SPARE_OFF)};
#ifndef NO_GOUT
                _Pragma("nounroll") for (int rep_ = REP_OUT; rep_ < 2; ++rep_) { E.dry = (rep_ == 0); pg8::gemm_phase<pg8::EpiOut, pg8::StaticOrder, true, true>(lds + RING_OFF, g, S, E); }
#endif
            }
            PH_END
        } else {
            PH_BEGIN
            {
                LAYER_VARS
                float* vec = (float*)(ws + WS_VEC);
                pg8::Gemm g{XB16, Wb + W_LIN + (size_t)j * 2048 * 1024, M, 2048, 1024}; pg8::StaticOrder S; S.init(M, 2048, G, bx);
                pg8::EpiIn<1> E{st_mix_in, vec + V_LIN + j * 2048, vec + V_TOTAL + V_LIN + j * 2048, (bf16*)T, nullptr, 0};
#ifndef NO_G1
                _Pragma("nounroll") for (int rep_ = REP_R1; rep_ < 2; ++rep_) { E.dry = (rep_ == 0); pg8::gemm_phase<pg8::EpiIn<1>, pg8::StaticOrder, true, true>(lds + RING_OFF, g, S, E); }
#endif
            }
            PH_END
            PH_BEGIN
            {
                LAYER_VARS
#ifndef NO_LRU
                _Pragma("nounroll") for (int rep_ = REP_R2; rep_ < 2; ++rep_)
                if (vcu < 256)
                    lru::phase(lds + RING_OFF, vcu, (bf16*)T, (bf16*)(T + 32 * MiB), (bf16*)(T + 64 * MiB), Wb + W_GA + (size_t)j * 8 * 16384, Wb + W_GX + (size_t)j * 8 * 16384,
                               INP(4) + (size_t)j * 4 * 1024, INP(5) + (size_t)j * 1024, INP(7) + (size_t)j * 1024, INP(9) + (size_t)j * 1024, INP(10) + (size_t)j * 1024);
#endif
            }
            PH_END
            PH_BEGIN
            {
                LAYER_VARS
                const float* lng = INP(14); const float* lnb = INP(15);
                pg8::Gemm g{(bf16*)(T + 64 * MiB), Wb + W_LOUT + (size_t)j * 1024 * 1024, M, 1024, 1024}; pg8::StaticOrder S; S.init(M, 1024, G, bx);
                pg8::EpiOut E{st_mix_in, lng + (size_t)(2 * layer - 1) * 1024, lnb + (size_t)(2 * layer - 1) * 1024, XB16, (bf16*)(ws + WS_LO16), st_mix_out, 0, (LAS float*)(lds + SPARE_OFF)};
#ifndef NO_GOUT
                _Pragma("nounroll") for (int rep_ = REP_OUT; rep_ < 2; ++rep_) { E.dry = (rep_ == 0); pg8::gemm_phase<pg8::EpiOut, pg8::StaticOrder, true, true>(lds + RING_OFF, g, S, E); }
#endif
            }
            PH_END
        }
        PH_BEGIN
        {
            LAYER_VARS
            float* vec = (float*)(ws + WS_VEC);
            pg8::Gemm g{XB16, Wb + W_FIN + (size_t)layer * 5632 * 1024, M, 5632, 1024}; pg8::StaticOrder S; S.init(M, 5632, G, bx);
            pg8::EpiIn<2> E{st_mix_out, vec + V_FIN + layer * 5632, vec + V_TOTAL + V_FIN + layer * 5632, (bf16*)T, nullptr, 0};
#ifndef NO_G2
            _Pragma("nounroll") for (int rep_ = REP_F1; rep_ < 2; ++rep_) { E.dry = (rep_ == 0); pg8::gemm_phase<pg8::EpiIn<2>, pg8::StaticOrder, true, true>(lds + RING_OFF, g, S, E); }
#endif
            if (layer + 1 < DEPTH && bx >= (M / 256) * (5632 / 256) - 5 * G && bx < G) {
                const int lane = threadIdx.x & 63, wave = __builtin_amdgcn_readfirstlane(threadIdx.x >> 6), first = (M / 256) * (5632 / 256) - 5 * G;
                convert_set(lds, ws, layer + 1, (bx - first) * NWAVES + wave, (G - first) * NWAVES, lane, 0);
            }
        }
        PH_END
        PH_BEGIN
        {
            LAYER_VARS
            const float* lng = INP(14); const float* lnb = INP(15);
            finalize_vec(ws, bx, G);
            pg8::Gemm g{(bf16*)T, Wb + W_FOUT + (size_t)layer * 1024 * 2816, M, 1024, 2816}; pg8::StaticOrder S; S.init(M, 1024, G, bx);
            pg8::EpiOut E{st_mix_out, lng + (size_t)(2 * layer) * 1024, lnb + (size_t)(2 * layer) * 1024, XB16, (bf16*)(ws + WS_LO16), st_ffn_out, 0, (LAS float*)(lds + SPARE_OFF)};
#ifndef NO_GOUT
            _Pragma("nounroll") for (int rep_ = REP_OUT; rep_ < 2; ++rep_) { E.dry = (rep_ == 0); pg8::gemm_phase<pg8::EpiOut, pg8::StaticOrder, true, true>(lds + RING_OFF, g, S, E); }
#endif
        }
        PH_END
    }
    PH_BEGIN
    {
        const int lane = threadIdx.x & 63, wave = __builtin_amdgcn_readfirstlane(threadIdx.x >> 6);
        const int gw = vcu * NWAVES + wave, NGW = G * NWAVES;
        const float* lg = INP(14) + 7 * 1024; const float* lb = INP(15) + 7 * 1024; float* pre = OUTP();
        f32x4 gv[4], bv[4];
#pragma unroll
        for (int jj = 0; jj < 4; ++jj) { gv[jj] = *((const GAS f32x4*)lg + lane + 64 * jj); bv[jj] = *((const GAS f32x4*)lb + lane + 64 * jj); }
        _Pragma("nounroll") for (int rep_ = REP_FIN; rep_ < 2; ++rep_)
        for (int m = gw; m < M; m += NGW) {
            GAS f32x4* xr = (GAS f32x4*)(pre + (size_t)m * DM) + lane;
            f32x4 v[4]; float s = 0.f;
            { const GAS unsigned long long* x8 = (const GAS unsigned long long*)((const bf16*)(ws + WS_XB16) + (size_t)m * DM) + lane;
              const GAS unsigned long long* y8 = (const GAS unsigned long long*)((const bf16*)(ws + WS_LO16) + (size_t)m * DM) + lane;
              _Pragma("unroll") for (int jj = 0; jj < 4; ++jj) { const unsigned long long w8 = x8[64 * jj], z8 = y8[64 * jj]; const unsigned lo_ = (unsigned)w8, hi_ = (unsigned)(w8 >> 32), lo2 = (unsigned)z8, hi2 = (unsigned)(z8 >> 32);
                  v[jj] = (f32x4){__uint_as_float(lo_ << 16) + __uint_as_float(lo2 << 16), __uint_as_float(lo_ & 0xffff0000u) + __uint_as_float(lo2 & 0xffff0000u),
                                  __uint_as_float(hi_ << 16) + __uint_as_float(hi2 << 16), __uint_as_float(hi_ & 0xffff0000u) + __uint_as_float(hi2 & 0xffff0000u)};
                  s += (v[jj].x + v[jj].y) + (v[jj].z + v[jj].w); } }
            const float mean = wave_sum(s) * (1.f / DM); float s2 = 0.f;
#pragma unroll
            for (int jj = 0; jj < 4; ++jj) { v[jj] = v[jj] - mean; s2 += (v[jj].x * v[jj].x + v[jj].y * v[jj].y) + (v[jj].z * v[jj].z + v[jj].w * v[jj].w); }
            const float rstd = 1.f / sqrtf(wave_sum(s2) * (1.f / DM) + 1e-5f);
#pragma unroll
            for (int jj = 0; jj < 4; ++jj) { const f32x4 o_ = v[jj] * rstd * gv[jj] + bv[jj]; if (rep_) xr[64 * jj] = o_; else asm volatile("" :: "v"(o_.x), "v"(o_.y), "v"(o_.z), "v"(o_.w)); }
        }
    }
    PH_END
#undef PH_BEGIN
#undef PH_END
#undef LAYER_VARS
}

extern "C" void kernel_launch(void* const* d_in, const int* in_sizes, int n_in, void* d_out, int out_size, void* d_ws, size_t ws_size, hipStream_t stream) {
    static int grid = 0;
    if (grid == 0) {
        if (n_in != 16 || in_sizes[0] != M * DM || out_size != M * DM || ws_size < WS_END) { fprintf(stderr, "kernel_launch: shape/workspace mismatch (n_in %d, in0 %d, out %d, ws %zu)\n", n_in, n_in > 0 ? in_sizes[0] : -1, out_size, ws_size); grid = -1; return; }
        int dev = 0, cus = 0, per_cu = 0;
        if (hipGetDevice(&dev) != hipSuccess || hipDeviceGetAttribute(&cus, hipDeviceAttributeMultiprocessorCount, dev) != hipSuccess) { fprintf(stderr, "kernel_launch: device query failed\n"); grid = -1; return; }
        if (hipFuncSetAttribute((const void*)mega_fwd, hipFuncAttributeMaxDynamicSharedMemorySize, LDS_BYTES) != hipSuccess) { fprintf(stderr, "kernel_launch: hipFuncSetAttribute failed\n"); grid = -1; return; }
        if (hipOccupancyMaxActiveBlocksPerMultiprocessor(&per_cu, (const void*)mega_fwd, NWAVES * 64, LDS_BYTES) != hipSuccess || per_cu < 1) { fprintf(stderr, "kernel_launch: occupancy query says %d blocks per CU\n", per_cu); grid = -1; (void)hipGetLastError(); return; }
        grid = cus;
        if (grid != 256) fprintf(stderr, "kernel_launch: %d CUs; this kernel is laid out for 256\n", grid);
    }
    if (grid < 0) return;
    if (hipMemsetAsync((char*)d_ws + WS_CTL, 0, ZERO_BYTES, stream) != hipSuccess) { fprintf(stderr, "kernel_launch: memset failed\n"); return; }
    Args a{};
    for (int i = 0; i < 16; ++i) a.in[i] = (const float*)d_in[i];
    a.out = (float*)d_out; a.ws = (unsigned char*)d_ws; a.ph_lo = 0; a.ph_hi = NPHASES;
    void* kargs[] = {&a};
    hipError_t e = hipLaunchCooperativeKernel((const void*)mega_fwd, dim3(grid), dim3(NWAVES * 64), kargs, LDS_BYTES, stream);
    if (e != hipSuccess) fprintf(stderr, "kernel_launch: cooperative launch failed: %s (grid %d)\n", hipGetErrorString(e), grid);
}
```
